# Optimizing an MI355X kernel written in HIP

```python
import jax
import jax.numpy as jnp
from jax import lax
import numpy as np

D_MODEL = 1024
BATCH = 2
SEQ = 8192
DEPTH = 1

EPS = 1e-6
ROPE_THETA = 10000.0
Q_BLOCK = 128

A_HEADS = 8
A_HEAD_DIM = 64
A_WIDTH = A_HEADS * A_HEAD_DIM
MOBA_BLOCK = 256
MOBA_TOPK = 3

B_HEADS = 8
B_NOPE = 64
B_ROPE = 32
B_QK = B_NOPE + B_ROPE
B_V = 64
B_Q_RANK = 384
B_KV_RANK = 256
B_WIDTH = B_HEADS * B_V

D_FF = 4 * D_MODEL

IN_SPLITS = (A_WIDTH, A_WIDTH, A_WIDTH, B_Q_RANK, B_KV_RANK, B_ROPE, D_MODEL, D_MODEL)
IN_WIDTH = sum(IN_SPLITS)

kernel_name = "hybrid_gated_moba_mla_block"


def rmsnorm(x, g):
    xf = x.astype(jnp.float32)
    y = xf * lax.rsqrt(jnp.mean(xf * xf, axis=-1, keepdims=True) + EPS)
    return (y * g.astype(jnp.float32)).astype(x.dtype)


def rope(x, pos):
    half = x.shape[-1] // 2
    inv_freq = jnp.power(ROPE_THETA, -jnp.arange(half, dtype=jnp.float32) / half)
    ang = pos.astype(jnp.float32)[:, None] * inv_freq[None, :]
    cos = jnp.cos(ang)[None, :, None, :]
    sin = jnp.sin(ang)[None, :, None, :]
    xf = x.astype(jnp.float32)
    x1, x2 = xf[..., :half], xf[..., half:]
    return jnp.concatenate([x1 * cos - x2 * sin, x2 * cos + x1 * sin], axis=-1).astype(x.dtype)


def moba_attention(q, k, v):
    b, h, s, dh = q.shape
    nb = -(-s // MOBA_BLOCK)
    pad = nb * MOBA_BLOCK - s
    padw = ((0, 0), (0, 0), (0, pad), (0, 0))
    kb = jnp.pad(k, padw).reshape(b, h, nb, MOBA_BLOCK, dh)
    vb = jnp.pad(v, padw).reshape(b, h, nb, MOBA_BLOCK, dh)
    k_mean = jnp.mean(kb.astype(jnp.float32), axis=3)
    topk = min(MOBA_TOPK, nb)
    scale = dh ** -0.5
    bi = jnp.arange(b)[:, None, None, None]
    hi = jnp.arange(h)[None, :, None, None]
    blk_ids = jnp.arange(nb)
    in_blk = jnp.arange(MOBA_BLOCK)

    def one_chunk(c):
        start = c * Q_BLOCK
        qc = lax.dynamic_slice_in_dim(q, start, Q_BLOCK, axis=2)
        qpos = start + jnp.arange(Q_BLOCK)
        qblk = start // MOBA_BLOCK
        gate = jnp.einsum('bhtd,bhnd->bhtn', qc.astype(jnp.float32), k_mean)
        gate = jnp.where(blk_ids < qblk, gate, -jnp.inf)
        _, sel = lax.top_k(gate, topk)
        valid = sel < qblk
        k_sel = kb[bi, hi, sel]
        v_sel = vb[bi, hi, sel]
        k_own = lax.dynamic_index_in_dim(kb, qblk, axis=2, keepdims=False)
        v_own = lax.dynamic_index_in_dim(vb, qblk, axis=2, keepdims=False)
        own_mask = (qblk * MOBA_BLOCK + in_blk)[None, :] <= qpos[:, None]
        s_sel = jnp.einsum('bhtd,bhtkld->bhtkl', qc, k_sel,
                           preferred_element_type=jnp.float32) * scale
        s_sel = jnp.where(valid[..., None], s_sel, -jnp.inf)
        s_own = jnp.einsum('bhtd,bhld->bhtl', qc, k_own,
                           preferred_element_type=jnp.float32) * scale
        s_own = jnp.where(own_mask, s_own, -jnp.inf)
        scores = jnp.concatenate(
            [s_sel.reshape(b, h, Q_BLOCK, topk * MOBA_BLOCK), s_own], axis=-1)
        p = jax.nn.softmax(scores, axis=-1).astype(v.dtype)
        p_sel = p[..., :topk * MOBA_BLOCK].reshape(b, h, Q_BLOCK, topk, MOBA_BLOCK)
        p_own = p[..., topk * MOBA_BLOCK:]
        return (jnp.einsum('bhtkl,bhtkld->bhtd', p_sel, v_sel)
                + jnp.einsum('bhtl,bhld->bhtd', p_own, v_own))

    out = lax.map(one_chunk, jnp.arange(s // Q_BLOCK))
    return jnp.moveaxis(out, 0, 2).reshape(b, h, s, dh)


def mla_attention(q_nope, q_rope, k_nope, k_rope, v):
    b, h, s, _ = q_nope.shape
    scale = B_QK ** -0.5
    kpos = jnp.arange(s)

    def one_chunk(c):
        start = c * Q_BLOCK
        qn = lax.dynamic_slice_in_dim(q_nope, start, Q_BLOCK, axis=2)
        qr = lax.dynamic_slice_in_dim(q_rope, start, Q_BLOCK, axis=2)
        qpos = start + jnp.arange(Q_BLOCK)
        sc = (jnp.einsum('bhtd,bhsd->bhts', qn, k_nope, preferred_element_type=jnp.float32)
              + jnp.einsum('bhtd,bsd->bhts', qr, k_rope, preferred_element_type=jnp.float32)) * scale
        sc = jnp.where(kpos[None, :] <= qpos[:, None], sc, -jnp.inf)
        p = jax.nn.softmax(sc, axis=-1).astype(v.dtype)
        return jnp.einsum('bhts,bhsd->bhtd', p, v)

    out = lax.map(one_chunk, jnp.arange(s // Q_BLOCK))
    return jnp.moveaxis(out, 0, 2).reshape(b, h, s, v.shape[-1])


def setup_inputs(seed: int = 0) -> dict:
    key = jax.random.key(seed)
    ks = jax.random.split(key, 15)

    def dense(k, fan_in, shape):
        return jax.random.normal(k, shape, jnp.float32) * fan_in ** -0.5

    def gain(k, shape):
        return 1.0 + 0.02 * jax.random.normal(k, shape, jnp.float32)

    return {
        "x": jax.random.normal(ks[0], (BATCH, SEQ, D_MODEL), jnp.float32),
        "g_mix": gain(ks[1], (DEPTH, D_MODEL)),
        "w_in": dense(ks[2], D_MODEL, (DEPTH, D_MODEL, IN_WIDTH)),
        "b_gate": 0.02 * jax.random.normal(ks[3], (DEPTH, 2, D_MODEL), jnp.float32),
        "g_cq": gain(ks[4], (DEPTH, B_Q_RANK)),
        "w_q_up": dense(ks[5], B_Q_RANK, (DEPTH, B_Q_RANK, B_HEADS * B_QK)),
        "g_ckv": gain(ks[6], (DEPTH, B_KV_RANK)),
        "w_kv_up": dense(ks[7], B_KV_RANK, (DEPTH, B_KV_RANK, B_HEADS * (B_NOPE + B_V))),
        "w_o_a": dense(ks[8], A_WIDTH, (DEPTH, A_WIDTH, D_MODEL)),
        "w_o_b": dense(ks[9], B_WIDTH, (DEPTH, B_WIDTH, D_MODEL)),
        "w_out": dense(ks[10], D_MODEL, (DEPTH, D_MODEL, D_MODEL)),
        "g_mlp": gain(ks[11], (DEPTH, D_MODEL)),
        "w_ff1": dense(ks[12], D_MODEL, (DEPTH, D_MODEL, D_FF)),
        "w_ff2": dense(ks[13], D_FF, (DEPTH, D_FF, D_MODEL)),
        "g_final": gain(ks[14], (D_MODEL,)),
    }


def reference(x, g_mix, w_in, b_gate, g_cq, w_q_up, g_ckv, w_kv_up, w_o_a, w_o_b,
              w_out, g_mlp, w_ff1, w_ff2, g_final):
    b, s, _ = x.shape
    pos = jnp.arange(s)
    offsets = [int(o) for o in np.cumsum(IN_SPLITS)[:-1]]
    for l in range(DEPTH):
        h = rmsnorm(x, g_mix[l])
        proj = jnp.einsum('bsd,de->bse', h, w_in[l])
        qa, ka, va, cq, ckv, kr, gate_a, gate_b = jnp.split(proj, offsets, axis=-1)

        qa = rope(qa.reshape(b, s, A_HEADS, A_HEAD_DIM), pos).transpose(0, 2, 1, 3)
        ka = rope(ka.reshape(b, s, A_HEADS, A_HEAD_DIM), pos).transpose(0, 2, 1, 3)
        va = va.reshape(b, s, A_HEADS, A_HEAD_DIM).transpose(0, 2, 1, 3)
        o_a = moba_attention(qa, ka, va).transpose(0, 2, 1, 3).reshape(b, s, A_WIDTH)

        qb = jnp.einsum('bsr,re->bse', rmsnorm(cq, g_cq[l]), w_q_up[l]).reshape(b, s, B_HEADS, B_QK)
        q_nope = qb[..., :B_NOPE].transpose(0, 2, 1, 3)
        q_rope = rope(qb[..., B_NOPE:], pos).transpose(0, 2, 1, 3)
        kv = jnp.einsum('bsr,re->bse', rmsnorm(ckv, g_ckv[l]), w_kv_up[l]).reshape(
            b, s, B_HEADS, B_NOPE + B_V)
        k_nope = kv[..., :B_NOPE].transpose(0, 2, 1, 3)
        v_b = kv[..., B_NOPE:].transpose(0, 2, 1, 3)
        k_rope = rope(kr[:, :, None, :], pos)[:, :, 0, :]
        o_b = mla_attention(q_nope, q_rope, k_nope, k_rope, v_b).transpose(0, 2, 1, 3).reshape(
            b, s, B_WIDTH)

        y_a = jnp.einsum('bse,ed->bsd', o_a, w_o_a[l])
        y_b = jnp.einsum('bse,ed->bsd', o_b, w_o_b[l])
        g_a = jax.nn.sigmoid(gate_a + b_gate[l, 0])
        g_b = jax.nn.sigmoid(gate_b + b_gate[l, 1])
        x = x + jnp.einsum('bsd,de->bse', g_a * y_a + g_b * y_b, w_out[l])

        h2 = rmsnorm(x, g_mlp[l])
        u = jax.nn.relu(jnp.einsum('bsd,df->bsf', h2, w_ff1[l]))
        x = x + jnp.einsum('bsf,fd->bsd', u * u, w_ff2[l])
    return rmsnorm(x, g_final)
```

```cpp
#include <hip/hip_runtime.h>
#include <hip/hip_cooperative_groups.h>
#include <cstdio>
#include <cstdint>
namespace cg = cooperative_groups;
namespace pg8 {
#define PG8_LAS __attribute__((address_space(3)))
typedef unsigned short bf16_t;
typedef short bf16x8 __attribute__((ext_vector_type(8)));
typedef float f32x4 __attribute__((ext_vector_type(4)));
typedef unsigned u32x4 __attribute__((ext_vector_type(4)));
constexpr int BM = 256, BK = 64, HALF = 128, HTB = HALF * BK * 2  , STAGE_BYTES = 8 * HTB, NXCD = 8, WGM = 8;

__host__ __device__ __forceinline__ int lds_byte(int r, int c) { const int st = (r >> 4) * 2 + (c >> 5), rr = r & 15, cc = c & 31, ob = rr * 64 + cc * 2; return st * 1024 + (ob ^ (((ob >> 9) & 1) << 5)); }
__host__ __device__ __forceinline__ void stage_rc(int b, int& R, int& C) { const int st = b / 1024, sb = b % 1024, swz = sb ^ (((sb >> 9) & 1) << 5); R = (st >> 1) * 16 + swz / 64; C = (st & 1) * 32 + (swz % 64) / 2; }
__host__ __device__ __forceinline__ int perm32(int rho) { const int n = rho >> 4, i = rho & 15; return 8 * (i >> 2) + 4 * n + (i & 3); }

struct Unit { int pm, pn; };
struct Gemm { const bf16_t* A; const bf16_t* Bt; int M, N, K; };

struct StaticOrder {
    int nM, nN, nwg, G, c;
    __host__ __device__ void init(int M, int N, int G_, int c_) { nM = M / BM; nN = N / BM; nwg = nM * nN; G = G_; c = c_; }
    __host__ __device__ bool next(int i, Unit& u) const {
        const long L = (long)i * G + c; if (L >= nwg) return false;
        int wgid = (int)L; { const int q = nwg / NXCD, r = nwg % NXCD, xcd = wgid % NXCD, off = wgid / NXCD; wgid = (xcd < r ? xcd * (q + 1) : r * (q + 1) + (xcd - r) * q) + off; }
        const int nig = WGM * nN, gid = wgid / nig, fm = gid * WGM, gsz = (nM - fm) < WGM ? (nM - fm) : WGM;
        u.pm = fm + ((wgid % nig) % gsz); u.pn = (wgid % nig) / gsz; return true;
    }
    __device__ __forceinline__ void a_ready(const Unit&) const {}
    __device__ __forceinline__ void done(const Unit&) const {}
};

__device__ __forceinline__ unsigned cvt_pk_bf16(float lo, float hi) { unsigned r; asm volatile("v_cvt_pk_bf16_f32 %0, %1, %2" : "=v"(r) : "v"(lo), "v"(hi)); return r; }
typedef float f32x2 __attribute__((ext_vector_type(2)));
template <class Epi, class Sched, bool ALIGN_EPI = false, bool SP2 = false>
__device__ __forceinline__ void gemm_phase(PG8_LAS unsigned char* lds, const Gemm g, const Sched& S, const Epi& E) {
    int tid_ = threadIdx.x; asm volatile("" : "+v"(tid_));
    const int tid = tid_, wid = __builtin_amdgcn_readfirstlane(tid >> 6), lane = tid & 63, wr = wid >> 2, wc = wid & 3, fr = lane & 15, fq = lane >> 4;
    const int K = g.K, nt = K / BK;
    unsigned voffA[2], voffB[2];
#pragma unroll
    for (int i = 0; i < 2; ++i) { int R, C; stage_rc(tid * 16 + i * 8192, R, C); const int Rb = Epi::PERM ? ((R & ~31) + perm32(R & 31)) : R;
        voffA[i] = (unsigned)(R * K + C) * 2u; voffB[i] = (unsigned)(Rb * K + C) * 2u; }
    const size_t kstep = (size_t)(BK * 2);
    const size_t hstep = (size_t)HALF * K * 2;
    const size_t tstep = 2 * hstep;
    const unsigned ldsw = (unsigned)wid * 1024u;
    const int aoff = lds_byte(wr * 64 + fr, fq * 8), boff = lds_byte(wc * 32 + fr, fq * 8);
#define PG8_SA(b, h) (((b) * 2 + (h)) * HTB)
#define PG8_SB(b, h) ((4 + (b) * 2 + (h)) * HTB)
#define PG8_STAGE(bufoff, gbase, voff) do { _Pragma("unroll") for (int _i = 0; _i < 2; ++_i) \
        __builtin_amdgcn_global_load_lds((const unsigned*)((const char*)(gbase) + (voff)[_i]), (PG8_LAS unsigned*)(lds + (bufoff) + ldsw + _i * 8192), 16, 0, 0); } while (0)
#define PG8_LDA(dst, b, h) do { _Pragma("unroll") for (int m = 0; m < 4; ++m) _Pragma("unroll") for (int k = 0; k < 2; ++k) dst[m][k] = *(const PG8_LAS bf16x8*)(lds + PG8_SA(b, h) + aoff + m * 2048 + k * 1024); } while (0)
#define PG8_LDB(dst, b, h) do { _Pragma("unroll") for (int n = 0; n < 2; ++n) _Pragma("unroll") for (int k = 0; k < 2; ++k) dst[n][k] = *(const PG8_LAS bf16x8*)(lds + PG8_SB(b, h) + boff + n * 2048 + k * 1024); } while (0)
#define PG8_MMA(ai, bj, At, Bt) do { __builtin_amdgcn_s_setprio(1); _Pragma("unroll") for (int m = 0; m < 4; ++m) _Pragma("unroll") for (int n = 0; n < 2; ++n) _Pragma("unroll") for (int k = 0; k < 2; ++k) \
        acc[ai][bj][m][n] = __builtin_amdgcn_mfma_f32_16x16x32_bf16(Bt[n][k], At[m][k], acc[ai][bj][m][n], 0, 0, 0); __builtin_amdgcn_s_setprio(0); } while (0)
#define PG8_WAIT_V(n) asm volatile("s_waitcnt vmcnt(" #n ")" ::: "memory")
#define PG8_WAIT_L(n) asm volatile("s_waitcnt lgkmcnt(" #n ")" ::: "memory")
#define PG8_BAR __builtin_amdgcn_s_barrier()
#define PG8_SCHED __builtin_amdgcn_sched_barrier(0)
    Unit cur, nxt; int ui = 0;
    if (!S.next(0, cur)) return;
    f32x4 acc[2][2][4][2];
#pragma unroll
    for (int a = 0; a < 2; ++a)
#pragma unroll
        for (int b = 0; b < 2; ++b)
#pragma unroll
            for (int m = 0; m < 4; ++m)
#pragma unroll
                for (int n = 0; n < 2; ++n) acc[a][b][m][n] = (f32x4){0.f, 0.f, 0.f, 0.f};
    bf16x8 At[4][2], B0[2][2], B1[2][2];
    const char* cA = (const char*)g.A + (size_t)cur.pm * tstep; const char* cB = (const char*)g.Bt + (size_t)cur.pn * tstep;
    S.a_ready(cur);
    if constexpr (SP2) {
        PG8_STAGE(PG8_SB(0, 0), cB, voffB); PG8_STAGE(PG8_SB(0, 1), cB + hstep, voffB); PG8_STAGE(PG8_SA(0, 0), cA, voffA); PG8_STAGE(PG8_SA(0, 1), cA + hstep, voffA);
        if (wr == 1) PG8_BAR;
        PG8_WAIT_V(2); PG8_BAR;
        PG8_STAGE(PG8_SB(1, 0), cB + kstep, voffB); PG8_STAGE(PG8_SA(1, 0), cA + kstep, voffA); PG8_STAGE(PG8_SB(1, 1), cB + hstep + kstep, voffB);
        PG8_WAIT_V(6); PG8_BAR;
    } else {
        PG8_STAGE(PG8_SB(0, 0), cB, voffB); PG8_STAGE(PG8_SA(0, 0), cA, voffA); PG8_STAGE(PG8_SB(0, 1), cB + hstep, voffB); PG8_STAGE(PG8_SA(0, 1), cA + hstep, voffA);
        if (wr == 1) PG8_BAR;
        PG8_WAIT_V(4); PG8_BAR;
        PG8_STAGE(PG8_SB(1, 0), cB + kstep, voffB); PG8_STAGE(PG8_SA(1, 0), cA + kstep, voffA); PG8_STAGE(PG8_SB(1, 1), cB + hstep + kstep, voffB);
        PG8_WAIT_V(6); PG8_BAR;
    }
    for (;;) {
        const bool has_next = S.next(ui + 1, nxt);
        const char* nA = has_next ? (const char*)g.A + (size_t)nxt.pm * tstep : cA; const char* nB = has_next ? (const char*)g.Bt + (size_t)nxt.pn * tstep : cB;
        for (int t = 0; t < nt; t += 2) {
            const bool last = (t == nt - 2);
            const char* a1 = cA + (size_t)(t + 1) * kstep;
            const char* a2 = last ? nA : cA + (size_t)(t + 2) * kstep; const char* b2 = last ? nB : cB + (size_t)(t + 2) * kstep;
            const char* a3 = a2 + kstep; const char* b3 = b2 + kstep;
            if (last && has_next) S.a_ready(nxt);
            if constexpr (SP2) {
            PG8_LDB(B0, 0, 0); PG8_LDB(B1, 0, 1); PG8_SCHED; PG8_LDA(At, 0, 0); PG8_STAGE(PG8_SA(1, 1), a1 + hstep, voffA);
            PG8_WAIT_V(8); PG8_WAIT_L(0); PG8_BAR; PG8_MMA(0, 0, At, B0); PG8_MMA(0, 1, At, B1); PG8_BAR; PG8_SCHED;
            PG8_LDA(At, 0, 1); PG8_STAGE(PG8_SB(0, 0), b2, voffB); PG8_STAGE(PG8_SB(0, 1), b2 + hstep, voffB); PG8_STAGE(PG8_SA(0, 0), a2, voffA);
            PG8_WAIT_V(8); PG8_WAIT_L(0); PG8_BAR; PG8_MMA(1, 0, At, B0); PG8_MMA(1, 1, At, B1); PG8_BAR; PG8_SCHED;
            PG8_LDB(B0, 1, 0); PG8_LDB(B1, 1, 1); PG8_SCHED; PG8_LDA(At, 1, 0); PG8_STAGE(PG8_SA(0, 1), a2 + hstep, voffA);
            PG8_WAIT_V(8); PG8_WAIT_L(0); PG8_BAR; PG8_MMA(0, 0, At, B0); PG8_MMA(0, 1, At, B1); PG8_BAR; PG8_SCHED;
            PG8_LDA(At, 1, 1); PG8_STAGE(PG8_SB(1, 0), b3, voffB); PG8_STAGE(PG8_SB(1, 1), b3 + hstep, voffB); PG8_STAGE(PG8_SA(1, 0), a3, voffA);
            PG8_WAIT_V(8); PG8_WAIT_L(0); PG8_BAR; PG8_MMA(1, 0, At, B0); PG8_MMA(1, 1, At, B1); PG8_BAR; PG8_SCHED;
            } else {
            PG8_LDB(B0, 0, 0); PG8_SCHED; PG8_LDA(At, 0, 0); PG8_STAGE(PG8_SA(1, 1), a1 + hstep, voffA);
            PG8_WAIT_L(8); PG8_BAR; PG8_WAIT_L(0); PG8_MMA(0, 0, At, B0); PG8_BAR; PG8_SCHED;
            PG8_LDB(B1, 0, 1); PG8_STAGE(PG8_SB(0, 0), b2, voffB);
            PG8_BAR; PG8_WAIT_L(0); PG8_MMA(0, 1, At, B1); PG8_BAR;
            PG8_LDA(At, 0, 1); PG8_STAGE(PG8_SA(0, 0), a2, voffA);
            PG8_BAR; PG8_WAIT_L(0); PG8_MMA(1, 0, At, B0); PG8_BAR; PG8_SCHED;
            PG8_STAGE(PG8_SB(0, 1), b2 + hstep, voffB);
            PG8_WAIT_V(6); PG8_BAR; PG8_MMA(1, 1, At, B1); PG8_BAR;
            PG8_LDB(B0, 1, 0); PG8_SCHED; PG8_LDA(At, 1, 0); PG8_STAGE(PG8_SA(0, 1), a2 + hstep, voffA);
            PG8_WAIT_L(8); PG8_BAR; PG8_WAIT_L(0); PG8_MMA(0, 0, At, B0); PG8_BAR; PG8_SCHED;
            PG8_LDB(B1, 1, 1); PG8_STAGE(PG8_SB(1, 0), b3, voffB);
            PG8_BAR; PG8_WAIT_L(0); PG8_MMA(0, 1, At, B1); PG8_BAR;
            PG8_LDA(At, 1, 1); PG8_STAGE(PG8_SA(1, 0), a3, voffA);
            PG8_BAR; PG8_WAIT_L(0); PG8_MMA(1, 0, At, B0); PG8_BAR; PG8_SCHED;
            PG8_STAGE(PG8_SB(1, 1), b3 + hstep, voffB);
            PG8_WAIT_V(6); PG8_BAR; PG8_MMA(1, 1, At, B1); PG8_BAR;
            }
        }
        if constexpr (ALIGN_EPI) { if (wr == 0) PG8_BAR; }
        if constexpr (!Epi::AFTER_DRAIN) { E(acc, cur, wr, wc, fr, fq); S.done(cur); }
        if (!has_next) break;
#pragma unroll
        for (int a = 0; a < 2; ++a)
#pragma unroll
            for (int b = 0; b < 2; ++b)
#pragma unroll
                for (int m = 0; m < 4; ++m)
#pragma unroll
                    for (int n = 0; n < 2; ++n) acc[a][b][m][n] = (f32x4){0.f, 0.f, 0.f, 0.f};
        cur = nxt; cA = nA; cB = nB; ++ui;
        if constexpr (ALIGN_EPI) { if (wr == 1) PG8_BAR; }
    }
    PG8_WAIT_V(0);
    if constexpr (!ALIGN_EPI) { if (wr == 0) PG8_BAR; }
    PG8_BAR;
    if constexpr (Epi::AFTER_DRAIN) { E.fused(acc, cur, wr, wc, fr, fq, lds, wid, lane); S.done(cur); }
#undef PG8_SA
#undef PG8_SB
#undef PG8_STAGE
#undef PG8_LDA
#undef PG8_LDB
#undef PG8_MMA
#undef PG8_WAIT_V
#undef PG8_WAIT_L
#undef PG8_BAR
#undef PG8_SCHED
}
}

#define LAS __attribute__((address_space(3)))
typedef unsigned short bf16_t;
typedef short bf16x8 __attribute__((ext_vector_type(8)));
typedef float f32x4 __attribute__((ext_vector_type(4)));
typedef float f32x16 __attribute__((ext_vector_type(16)));
typedef unsigned u32x2 __attribute__((ext_vector_type(2)));
typedef unsigned u32x4 __attribute__((ext_vector_type(4)));

constexpr int SEQ = 8192, NBATCH = 2, M = NBATCH * SEQ, DM = 1024, FF = 4096;
constexpr int NIN = 4352;
constexpr float EPS = 1e-6f;
constexpr float LOG2E = 1.4426950408889634f;
constexpr float C_A = 0.125f * LOG2E;
constexpr float C_B = 0.10206207261596575f * LOG2E;
constexpr size_t MiB = 1u << 20;
constexpr size_t WS_ROWSS_Q = 0, WS_ROWSS_KV = 65536, WS_ROWSS2 = 131072, WS_KMEAN = 196608, WS_CTL_END = 327680;
constexpr size_t WS_WIN = 1 * MiB, WS_WQUP = 10 * MiB, WS_WKVUP = 11 * MiB, WS_WOA = 12 * MiB, WS_WOB = 13 * MiB, WS_WOUT = 14 * MiB, WS_WFF1 = 16 * MiB, WS_WFF2 = 24 * MiB;
constexpr size_t WS_ROPE64 = 32 * MiB, WS_ROPE32 = 34 * MiB;
constexpr size_t WS_XN = 36 * MiB, WS_OA = 36 * MiB, WS_OB = 52 * MiB, WS_X1B = 36 * MiB;
constexpr size_t WS_QA = 68 * MiB, WS_KA = 84 * MiB, WS_VA = 100 * MiB, WS_CQ = 116 * MiB, WS_CKV = 128 * MiB, WS_QB = 138 * MiB, WS_KB = 162 * MiB, WS_VB = 186 * MiB;
constexpr size_t WS_Z = 68 * MiB, WS_U = 68 * MiB, WS_END = 202 * MiB;
constexpr int LDS_BYTES = 147456;
constexpr int NTHREADS = 512;

typedef float f32x2_t __attribute__((ext_vector_type(2))); typedef __bf16 bf16x2_t __attribute__((ext_vector_type(2)));
__device__ __forceinline__ unsigned cvtpk(float lo, float hi) { f32x2_t v = {lo, hi}; bf16x2_t b = __builtin_convertvector(v, bf16x2_t); return __builtin_bit_cast(unsigned, b); }
__device__ __forceinline__ void st4(bf16_t* p, f32x4 v) { u32x2 w; w.x = cvtpk(v[0], v[1]); w.y = cvtpk(v[2], v[3]); *(u32x2*)p = w; }
__device__ __forceinline__ float bf2f(unsigned short s) { return __uint_as_float(((unsigned)s) << 16); }
__device__ __forceinline__ f32x4 ld4bf(const bf16_t* p) { const u32x2 w = *(const u32x2*)p; return (f32x4){__uint_as_float(w.x << 16), __uint_as_float(w.x & 0xffff0000u), __uint_as_float(w.y << 16), __uint_as_float(w.y & 0xffff0000u)}; }
__device__ __forceinline__ float wave_sum(float v) {
#pragma unroll
    for (int o = 1; o < 64; o <<= 1) v += __shfl_xor(v, o);
    return v;
}

#define EPI_ROWS(ai, m) for (int ai = 0; ai < 2; ++ai) _Pragma("unroll") for (int m = 0; m < 4; ++m)

struct EpiProj {
    static constexpr bool PERM = false, AFTER_DRAIN = false;
    bf16_t *QA, *KA, *VA, *CQ, *CKV, *KB, *G; float *ROWSS_Q, *ROWSS_KV, *KMEAN; const float *ROPE64, *ROPE32, *b_gate;
    __device__ __forceinline__ void operator()(const f32x4 (&acc)[2][2][4][2], const pg8::Unit& u, int wr, int wc, int fr, int fq) const {
        const int pn = u.pn; const int row0 = u.pm * 256 + wr * 64 + fr; const int cl = wc * 32 + 4 * fq;
        if (pn < 4) {
            bf16_t* dst = pn < 2 ? QA : KA; const int cbase = (pn & 1) * 256; const float sc = pn < 2 ? C_A : 1.f; const int fi = 16 * (wc & 1) + 4 * fq;
            f32x4 ks[2][2];
#pragma unroll
            for (int bj = 0; bj < 2; ++bj) { ks[bj][0] = (f32x4){0.f, 0.f, 0.f, 0.f}; ks[bj][1] = (f32x4){0.f, 0.f, 0.f, 0.f}; }
#pragma unroll
            EPI_ROWS(ai, m) {
                const int row = row0 + 128 * ai + 16 * m; const int pos = row & (SEQ - 1);
                const f32x4* rp = (const f32x4*)(ROPE64 + ((size_t)pos * 32 + fi) * 2); const f32x4 r01 = rp[0], r23 = rp[1];
                const f32x4 c = (f32x4){r01[0], r01[2], r23[0], r23[2]}, s = (f32x4){r01[1], r01[3], r23[1], r23[3]};
#pragma unroll
                for (int bj = 0; bj < 2; ++bj) {
                    const f32x4 x1 = acc[ai][bj][m][0], x2 = acc[ai][bj][m][1];
                    const f32x4 o1 = x1 * c - x2 * s, o2 = x2 * c + x1 * s;
                    ks[bj][0] += o1; ks[bj][1] += o2;
                    bf16_t* p = dst + (size_t)row * 512 + cbase + 128 * bj + cl;
                    st4(p, o1 * sc); st4(p + 16, o2 * sc);
                }
            }
            if (pn >= 2) {
#pragma unroll
                for (int bj = 0; bj < 2; ++bj)
#pragma unroll
                    for (int n = 0; n < 2; ++n)
#pragma unroll
                        for (int j = 0; j < 4; ++j) { float v = ks[bj][n][j]; v += __shfl_xor(v, 1); v += __shfl_xor(v, 2); v += __shfl_xor(v, 4); v += __shfl_xor(v, 8);
                            if (fr == 0) unsafeAtomicAdd(KMEAN + (size_t)u.pm * 512 + cbase + 128 * bj + cl + 16 * n + j, v * (1.f / 256.f)); }
            }
        } else if (pn < 6) {
            const int cbase = (pn - 4) * 256;
#pragma unroll
            EPI_ROWS(ai, m) { const int row = row0 + 128 * ai + 16 * m;
#pragma unroll
                for (int bj = 0; bj < 2; ++bj)
#pragma unroll
                    for (int n = 0; n < 2; ++n) st4(VA + (size_t)row * 512 + cbase + 128 * bj + cl + 16 * n, acc[ai][bj][m][n]); }
        } else if (pn < 9) {
#pragma unroll
            EPI_ROWS(ai, m) { const int row = row0 + 128 * ai + 16 * m; float sq = 0.f, skv = 0.f;
#pragma unroll
                for (int bj = 0; bj < 2; ++bj) {
                    const f32x4 v0 = acc[ai][bj][m][0], v1 = acc[ai][bj][m][1];
                    const float ss = (v0[0] * v0[0] + v0[1] * v0[1]) + (v0[2] * v0[2] + v0[3] * v0[3]) + (v1[0] * v1[0] + v1[1] * v1[1]) + (v1[2] * v1[2] + v1[3] * v1[3]);
                    const int sel = (pn - 6) * 2 + bj;
                    if (sel < 3) { sq += ss; bf16_t* p = CQ + (size_t)row * 384 + 128 * sel + cl; st4(p, v0); st4(p + 16, v1); }
                    else if (sel < 5) { skv += ss; bf16_t* p = CKV + (size_t)row * 256 + 128 * (sel - 3) + cl; st4(p, v0); st4(p + 16, v1); }
                    else if (wc == 0) {
                        const int pos = row & (SEQ - 1);
                        const f32x4* rp = (const f32x4*)(ROPE32 + ((size_t)pos * 16 + 4 * fq) * 2); const f32x4 r01 = rp[0], r23 = rp[1];
                        const f32x4 c = (f32x4){r01[0], r01[2], r23[0], r23[2]}, s = (f32x4){r01[1], r01[3], r23[1], r23[3]};
                        const f32x4 o1 = v0 * c - v1 * s, o2 = v1 * c + v0 * s;
#pragma unroll
                        for (int h = 0; h < 8; ++h) { bf16_t* p = KB + (size_t)row * 768 + 96 * h + 64 + 4 * fq; st4(p, o1); st4(p + 16, o2); }
                    }
                }
                if (pn < 8) { sq += __shfl_xor(sq, 16); sq += __shfl_xor(sq, 32); if (fq == 0) unsafeAtomicAdd(ROWSS_Q + row, sq); }
                if (pn > 6) { skv += __shfl_xor(skv, 16); skv += __shfl_xor(skv, 32); if (fq == 0) unsafeAtomicAdd(ROWSS_KV + row, skv); }
            }
        } else {
            const int gbase = (pn - 9) * 256;
#pragma unroll
            for (int bj = 0; bj < 2; ++bj)
#pragma unroll
                for (int n = 0; n < 2; ++n) {
                    const int gc = gbase + 128 * bj + cl + 16 * n; const f32x4 bv = *(const f32x4*)(b_gate + gc);
                    bf16_t* dst = G + (size_t)(gc >> 10) * ((size_t)M * 1024) + (gc & 1023);
#pragma unroll
                    EPI_ROWS(ai, m) { const int row = row0 + 128 * ai + 16 * m; f32x4 v = acc[ai][bj][m][n] + bv;
#pragma unroll
                        for (int j = 0; j < 4; ++j) v[j] = __builtin_amdgcn_rcpf(1.f + __builtin_amdgcn_exp2f(-LOG2E * v[j]));
                        st4(dst + (size_t)row * 1024, v); }
                }
        }
    }
};
struct EpiQup {
    static constexpr bool PERM = false, AFTER_DRAIN = false;
    bf16_t* QB; const float *ROWSS_Q, *ROPE32;
    __device__ __forceinline__ void operator()(const f32x4 (&acc)[2][2][4][2], const pg8::Unit& u, int wr, int wc, int fr, int fq) const {
        const int row0 = u.pm * 256 + wr * 64 + fr;
#pragma unroll
        EPI_ROWS(ai, m) { const int row = row0 + 128 * ai + 16 * m; const float rs = rsqrtf(ROWSS_Q[row] * (1.f / 384.f) + EPS) * C_B; const int pos = row & (SEQ - 1);
#pragma unroll
            for (int bj = 0; bj < 2; ++bj) {
                const int grp = 8 * u.pn + 4 * bj + wc; const int part = grp % 3;
                f32x4 v0 = acc[ai][bj][m][0] * rs, v1 = acc[ai][bj][m][1] * rs;
                if (part == 2) {
                    const f32x4* rp = (const f32x4*)(ROPE32 + ((size_t)pos * 16 + 4 * fq) * 2); const f32x4 r01 = rp[0], r23 = rp[1];
                    const f32x4 c = (f32x4){r01[0], r01[2], r23[0], r23[2]}, s = (f32x4){r01[1], r01[3], r23[1], r23[3]};
                    const f32x4 o1 = v0 * c - v1 * s, o2 = v1 * c + v0 * s; v0 = o1; v1 = o2;
                }
                bf16_t* p = QB + (size_t)row * 768 + 32 * grp + 4 * fq; st4(p, v0); st4(p + 16, v1);
            } }
    }
};
struct EpiKVup {
    static constexpr bool PERM = false, AFTER_DRAIN = false;
    bf16_t *KB, *VB; const float* ROWSS_KV;
    __device__ __forceinline__ void operator()(const f32x4 (&acc)[2][2][4][2], const pg8::Unit& u, int wr, int wc, int fr, int fq) const {
        const int row0 = u.pm * 256 + wr * 64 + fr;
#pragma unroll
        EPI_ROWS(ai, m) { const int row = row0 + 128 * ai + 16 * m; const float rs = rsqrtf(ROWSS_KV[row] * (1.f / 256.f) + EPS);
#pragma unroll
            for (int bj = 0; bj < 2; ++bj) { const int head = 2 * u.pn + bj;
                bf16_t* p = (wc < 2) ? KB + (size_t)row * 768 + 96 * head + 32 * wc + 4 * fq : VB + (size_t)row * 512 + 64 * head + 32 * (wc - 2) + 4 * fq;
                st4(p, acc[ai][bj][m][0] * rs); st4(p + 16, acc[ai][bj][m][1] * rs); } }
    }
};
template <bool ADD> struct EpiGate {
    static constexpr bool PERM = false, AFTER_DRAIN = false;
    bf16_t* Z; const bf16_t* Gt;
    __device__ __forceinline__ void operator()(const f32x4 (&acc)[2][2][4][2], const pg8::Unit& u, int wr, int wc, int fr, int fq) const {
        const int row0 = u.pm * 256 + wr * 64 + fr; const int col0 = u.pn * 256 + wc * 32 + 4 * fq;
#pragma unroll
        EPI_ROWS(ai, m) { const size_t ro = (size_t)(row0 + 128 * ai + 16 * m) * 1024 + col0;
#pragma unroll
            for (int bj = 0; bj < 2; ++bj)
#pragma unroll
                for (int n = 0; n < 2; ++n) { const size_t o = ro + 128 * bj + 16 * n; f32x4 v = acc[ai][bj][m][n] * ld4bf(Gt + o); if (ADD) v += ld4bf(Z + o); st4(Z + o, v); } }
    }
};
struct EpiOut {
    static constexpr bool PERM = false, AFTER_DRAIN = false;
    const float* X; float* X1; bf16_t* X1B; float* ROWSS2;
    __device__ __forceinline__ void operator()(const f32x4 (&acc)[2][2][4][2], const pg8::Unit& u, int wr, int wc, int fr, int fq) const {
        const int row0 = u.pm * 256 + wr * 64 + fr; const int col0 = u.pn * 256 + wc * 32 + 4 * fq;
#pragma unroll
        EPI_ROWS(ai, m) { const int row = row0 + 128 * ai + 16 * m; const size_t ro = (size_t)row * 1024 + col0; float ss = 0.f;
#pragma unroll
            for (int bj = 0; bj < 2; ++bj)
#pragma unroll
                for (int n = 0; n < 2; ++n) { const size_t o = ro + 128 * bj + 16 * n; const f32x4 v = acc[ai][bj][m][n] + *(const f32x4*)(X + o);
                    ss += (v[0] * v[0] + v[1] * v[1]) + (v[2] * v[2] + v[3] * v[3]); *(f32x4*)(X1 + o) = v; st4(X1B + o, v); }
            ss += __shfl_xor(ss, 16); ss += __shfl_xor(ss, 32); if (fq == 0) unsafeAtomicAdd(ROWSS2 + row, ss); }
    }
};
struct EpiFF1 {
    static constexpr bool PERM = false, AFTER_DRAIN = false;
    bf16_t* U; const float* ROWSS2;
    __device__ __forceinline__ void operator()(const f32x4 (&acc)[2][2][4][2], const pg8::Unit& u, int wr, int wc, int fr, int fq) const {
        const int row0 = u.pm * 256 + wr * 64 + fr; const int col0 = u.pn * 256 + wc * 32 + 4 * fq;
#pragma unroll
        EPI_ROWS(ai, m) { const int row = row0 + 128 * ai + 16 * m; const float r2 = 1.f / (ROWSS2[row] * (1.f / 1024.f) + EPS);
#pragma unroll
            for (int bj = 0; bj < 2; ++bj)
#pragma unroll
                for (int n = 0; n < 2; ++n) { f32x4 v = acc[ai][bj][m][n];
#pragma unroll
                    for (int j = 0; j < 4; ++j) { const float t = fmaxf(v[j], 0.f); v[j] = t * t * r2; }
                    st4(U + (size_t)row * FF + col0 + 128 * bj + 16 * n, v); } }
    }
};
struct EpiFF2 {
    static constexpr bool PERM = false, AFTER_DRAIN = false;
    float* X1;
    __device__ __forceinline__ void operator()(const f32x4 (&acc)[2][2][4][2], const pg8::Unit& u, int wr, int wc, int fr, int fq) const {
        const int row0 = u.pm * 256 + wr * 64 + fr; const int col0 = u.pn * 256 + wc * 32 + 4 * fq;
#pragma unroll
        EPI_ROWS(ai, m) { const size_t ro = (size_t)(row0 + 128 * ai + 16 * m) * 1024 + col0;
#pragma unroll
            for (int bj = 0; bj < 2; ++bj)
#pragma unroll
                for (int n = 0; n < 2; ++n) { float* p = X1 + ro + 128 * bj + 16 * n; *(f32x4*)p = *(const f32x4*)p + acc[ai][bj][m][n]; } }
    }
};

__device__ __forceinline__ int crow(int r, int hi) { return (r & 3) + 8 * (r >> 2) + 4 * hi; }
template <int DQK, bool MOBA>
__device__ __forceinline__ void attn_unit(int b, int h, int qb, const bf16_t* __restrict__ Qg, const bf16_t* __restrict__ Kg, const bf16_t* __restrict__ Vg, bf16_t* __restrict__ Og,
                                          const float* __restrict__ kmean, LAS unsigned char* lds) {
    constexpr int LDQ = 8 * DQK, ND = DQK / 16, KP = DQK * 2 + 16, VP = 144, KBYTES = 64 * KP, BUF = KBYTES + 64 * VP;
    constexpr int KCH = DQK / 8;
    LAS unsigned* uni = (LAS unsigned*)(lds + 2 * BUF);
    LAS int* tl = (LAS int*)(lds + 2 * BUF + 64);
    int tid_ = threadIdx.x; asm volatile("" : "+v"(tid_));
    const int tid = tid_, lane = tid & 63, wid = __builtin_amdgcn_readfirstlane(tid >> 6), r32 = lane & 31, hi = lane >> 5;
    const size_t rowbase = (size_t)b * SEQ; const int q0 = qb * 256;
    bf16x8 qf[ND];
    { const bf16_t* qrow = Qg + (rowbase + q0 + wid * 32 + r32) * LDQ + h * DQK + 8 * hi;
#pragma unroll
      for (int d0 = 0; d0 < ND; ++d0) qf[d0] = *(const bf16x8*)(qrow + 16 * d0); }
    unsigned selmask = 0u;
    if constexpr (MOBA) {
        float v1 = -INFINITY, v2 = -INFINITY, v3 = -INFINITY; int i1 = -1, i2 = -1, i3 = -1;
        for (int j = 0; j < qb; ++j) {
            const float* km = kmean + (size_t)(b * 32 + j) * 512 + h * 64 + 8 * hi; float s = 0.f;
#pragma unroll
            for (int d0 = 0; d0 < 4; ++d0) { const f32x4 a = *(const f32x4*)(km + 16 * d0), c = *(const f32x4*)(km + 16 * d0 + 4);
                s += bf2f((unsigned short)qf[d0][0]) * a[0] + bf2f((unsigned short)qf[d0][1]) * a[1] + bf2f((unsigned short)qf[d0][2]) * a[2] + bf2f((unsigned short)qf[d0][3]) * a[3]
                   + bf2f((unsigned short)qf[d0][4]) * c[0] + bf2f((unsigned short)qf[d0][5]) * c[1] + bf2f((unsigned short)qf[d0][6]) * c[2] + bf2f((unsigned short)qf[d0][7]) * c[3]; }
            s += __shfl_xor(s, 32);
            if (s > v1) { v3 = v2; i3 = i2; v2 = v1; i2 = i1; v1 = s; i1 = j; }
            else if (s > v2) { v3 = v2; i3 = i2; v2 = s; i2 = j; }
            else if (s > v3) { v3 = s; i3 = j; }
        }
        if (i1 >= 0) selmask |= 1u << i1; if (i2 >= 0) selmask |= 1u << i2; if (i3 >= 0) selmask |= 1u << i3;
        unsigned um = selmask;
#pragma unroll
        for (int o = 1; o < 64; o <<= 1) um |= (unsigned)__shfl_xor((int)um, o);
        if (lane == 0) uni[wid] = um;
        __syncthreads();
    }
    unsigned um;
    if constexpr (MOBA) { um = 0u;
#pragma unroll
        for (int w = 0; w < 8; ++w) um |= uni[w]; um = (unsigned)__builtin_amdgcn_readfirstlane((int)um); }
    else um = (qb == 0) ? 0u : (0xffffffffu >> (32 - qb));
    const int nblk = __builtin_popcount(um); const int nt = 4 * (nblk + 1);
    if (tid < 32) { if ((um >> tid) & 1u) { const int idx = __builtin_popcount(um & ((1u << tid) - 1u));
#pragma unroll
            for (int s = 0; s < 4; ++s) tl[4 * idx + s] = 256 * tid + 64 * s; } }
    else if (tid == 32) {
#pragma unroll
        for (int s = 0; s < 4; ++s) tl[4 * nblk + s] = q0 + 64 * s; }
    __syncthreads();
    const int kr0 = (KCH == 8) ? (tid >> 3) : (tid / 12), kc0 = (KCH == 8) ? (tid & 7) : (tid % 12);
    const int kr1 = (tid + 512) / 12, kc1 = (tid + 512) % 12; const bool has2 = (KCH == 12) && (tid < 256);
    const bf16_t* Kh = Kg + rowbase * LDQ + h * DQK; const bf16_t* Vh = Vg + rowbase * 512 + h * 64;
    const int vkv = tid & 63, vdg = tid >> 6;
    u32x4 kreg0, kreg1 = (u32x4){0u, 0u, 0u, 0u}, vreg;
#define ATT_LOAD(kv0) do { kreg0 = *(const u32x4*)(Kh + (size_t)((kv0) + kr0) * LDQ + 8 * kc0); if (has2) kreg1 = *(const u32x4*)(Kh + (size_t)((kv0) + kr1) * LDQ + 8 * kc1); \
        vreg = *(const u32x4*)(Vh + (size_t)((kv0) + vkv) * 512 + 8 * vdg); } while (0)
#define ATT_STORE(buf) do { LAS unsigned char* kb_ = lds + (buf) * BUF; *(LAS u32x4*)(kb_ + kr0 * KP + 16 * kc0) = kreg0; if (has2) *(LAS u32x4*)(kb_ + kr1 * KP + 16 * kc1) = kreg1; \
        LAS unsigned char* vb_ = kb_ + KBYTES + (8 * vdg) * VP + 2 * vkv; \
        *(LAS unsigned short*)(vb_ + 0 * VP) = (unsigned short)(vreg.x & 0xffffu); *(LAS unsigned short*)(vb_ + 1 * VP) = (unsigned short)(vreg.x >> 16); \
        *(LAS unsigned short*)(vb_ + 2 * VP) = (unsigned short)(vreg.y & 0xffffu); *(LAS unsigned short*)(vb_ + 3 * VP) = (unsigned short)(vreg.y >> 16); \
        *(LAS unsigned short*)(vb_ + 4 * VP) = (unsigned short)(vreg.z & 0xffffu); *(LAS unsigned short*)(vb_ + 5 * VP) = (unsigned short)(vreg.z >> 16); \
        *(LAS unsigned short*)(vb_ + 6 * VP) = (unsigned short)(vreg.w & 0xffffu); *(LAS unsigned short*)(vb_ + 7 * VP) = (unsigned short)(vreg.w >> 16); } while (0)
    ATT_LOAD(tl[0]); ATT_STORE(0);
    __syncthreads();
    f32x16 o0, o1;
#pragma unroll
    for (int r = 0; r < 16; ++r) { o0[r] = 0.f; o1[r] = 0.f; }
    float mrun = -1e30f, lrun = 0.f;
    for (int it = 0; it < nt; ++it) {
        const int kv0 = tl[it]; const int blk = kv0 >> 8; const bool diag = (blk == qb);
        const bool more = (it + 1 < nt);
        if (more) { const int kvn = tl[it + 1]; ATT_LOAD(kvn); }
        const LAS unsigned char* kb = lds + (it & 1) * BUF; const LAS unsigned char* vb = kb + KBYTES;
        const bool active = !(diag && (kv0 - q0) > 32 * wid + 31);
        if (active) {
            f32x16 s0, s1;
#pragma unroll
            for (int r = 0; r < 16; ++r) { s0[r] = 0.f; s1[r] = 0.f; }
#pragma unroll
            for (int d0 = 0; d0 < ND; ++d0) {
                const bf16x8 a0 = *(const LAS bf16x8*)(kb + r32 * KP + (16 * d0 + 8 * hi) * 2);
                const bf16x8 a1 = *(const LAS bf16x8*)(kb + (32 + r32) * KP + (16 * d0 + 8 * hi) * 2);
                s0 = __builtin_amdgcn_mfma_f32_32x32x16_bf16(a0, qf[d0], s0, 0, 0, 0);
                s1 = __builtin_amdgcn_mfma_f32_32x32x16_bf16(a1, qf[d0], s1, 0, 0, 0);
            }
            if (diag) { const int qrel = 32 * wid + r32 - (kv0 - q0);
#pragma unroll
                for (int r = 0; r < 16; ++r) { const int kvr = crow(r, hi); if (kvr > qrel) s0[r] = -INFINITY; if (kvr + 32 > qrel) s1[r] = -INFINITY; } }
            else if (MOBA) { if (!((selmask >> blk) & 1u)) {
#pragma unroll
                    for (int r = 0; r < 16; ++r) { s0[r] = -INFINITY; s1[r] = -INFINITY; } } }
            float mx = fmaxf(s0[0], s1[0]);
#pragma unroll
            for (int r = 1; r < 16; ++r) mx = fmaxf(mx, fmaxf(s0[r], s1[r]));
            mx = fmaxf(mx, __shfl_xor(mx, 32));
            const float mnew = fmaxf(mrun, mx); const float alpha = __builtin_amdgcn_exp2f(mrun - mnew); mrun = mnew;
            float ls = 0.f;
#pragma unroll
            for (int r = 0; r < 16; ++r) { s0[r] = __builtin_amdgcn_exp2f(s0[r] - mnew); s1[r] = __builtin_amdgcn_exp2f(s1[r] - mnew); ls += s0[r] + s1[r]; }
            lrun = lrun * alpha + ls;
#pragma unroll
            for (int r = 0; r < 16; ++r) { o0[r] *= alpha; o1[r] *= alpha; }
#pragma unroll
            for (int kt = 0; kt < 2; ++kt)
#pragma unroll
                for (int uu = 0; uu < 2; ++uu) {
                    u32x4 pw;
                    if (kt == 0) { pw.x = cvtpk(s0[8 * uu + 0], s0[8 * uu + 1]); pw.y = cvtpk(s0[8 * uu + 2], s0[8 * uu + 3]); pw.z = cvtpk(s0[8 * uu + 4], s0[8 * uu + 5]); pw.w = cvtpk(s0[8 * uu + 6], s0[8 * uu + 7]); }
                    else         { pw.x = cvtpk(s1[8 * uu + 0], s1[8 * uu + 1]); pw.y = cvtpk(s1[8 * uu + 2], s1[8 * uu + 3]); pw.z = cvtpk(s1[8 * uu + 4], s1[8 * uu + 5]); pw.w = cvtpk(s1[8 * uu + 6], s1[8 * uu + 7]); }
                    const bf16x8 pb = __builtin_bit_cast(bf16x8, pw);
                    const int kvo = (32 * kt + 16 * uu + 4 * hi) * 2;
#pragma unroll
                    for (int dt = 0; dt < 2; ++dt) {
                        const LAS unsigned char* vp = vb + (32 * dt + r32) * VP + kvo;
                        u32x4 vw; const u32x2 lo = *(const LAS u32x2*)vp, hi2 = *(const LAS u32x2*)(vp + 16); vw.x = lo.x; vw.y = lo.y; vw.z = hi2.x; vw.w = hi2.y;
                        const bf16x8 va = __builtin_bit_cast(bf16x8, vw);
                        if (dt == 0) o0 = __builtin_amdgcn_mfma_f32_32x32x16_bf16(va, pb, o0, 0, 0, 0); else o1 = __builtin_amdgcn_mfma_f32_32x32x16_bf16(va, pb, o1, 0, 0, 0);
                    }
                }
        }
        if (more) ATT_STORE((it + 1) & 1);
        __syncthreads();
    }
#undef ATT_LOAD
#undef ATT_STORE
    lrun += __shfl_xor(lrun, 32);
    const float inv = 1.f / lrun;
    bf16_t* orow = Og + (rowbase + q0 + wid * 32 + r32) * 512 + h * 64 + 4 * hi;
#pragma unroll
    for (int g = 0; g < 4; ++g) {
        st4(orow + 8 * g, (f32x4){o0[4 * g] * inv, o0[4 * g + 1] * inv, o0[4 * g + 2] * inv, o0[4 * g + 3] * inv});
        st4(orow + 32 + 8 * g, (f32x4){o1[4 * g] * inv, o1[4 * g + 1] * inv, o1[4 * g + 2] * inv, o1[4 * g + 3] * inv});
    }
}

__device__ __forceinline__ int win_src_col(int p) {
    if (p < 1024) { const int base = p & ~63, w = p & 63, g = w >> 5, ww = w & 31; return base + (ww < 16 ? 16 * g + ww : 32 + 16 * g + (ww - 16)); }
    if (p < 2208) return p;
    if (p < 2304) return -1;
    return p - 96;
}
__device__ __forceinline__ void transpose_item(const float* __restrict__ W, int K, int Nsrc, int nblk, bf16_t* WT, const float* gk, bool winmap, LAS float* scr, int item, int lane) {
    const int kb = item / nblk, nb = item % nblk, k0 = 64 * kb, n0 = 32 * nb;
    const int np = n0 + (lane & 31); const int sc = winmap ? win_src_col(np) : np;
#pragma unroll 8
    for (int i = 0; i < 32; ++i) { const int kk = 2 * i + (lane >> 5); float v = (sc >= 0) ? W[(size_t)(k0 + kk) * Nsrc + sc] : 0.f; if (gk) v *= gk[k0 + kk]; scr[kk * 33 + (lane & 31)] = v; }
    asm volatile("s_waitcnt lgkmcnt(0)" ::: "memory");
    const int c = lane & 7;
#pragma unroll
    for (int j = 0; j < 4; ++j) { const int n = (lane >> 3) + 8 * j; const LAS float* s = scr + (8 * c) * 33 + n;
        u32x4 o; o.x = cvtpk(s[0 * 33], s[1 * 33]); o.y = cvtpk(s[2 * 33], s[3 * 33]); o.z = cvtpk(s[4 * 33], s[5 * 33]); o.w = cvtpk(s[6 * 33], s[7 * 33]);
        *(u32x4*)(WT + (size_t)(n0 + n) * K + k0 + 8 * c) = o; }
    asm volatile("s_waitcnt lgkmcnt(0)" ::: "memory");
}

#define GRID_SYNC() do { asm volatile("s_waitcnt vmcnt(0) lgkmcnt(0)" ::: "memory"); __builtin_amdgcn_fence(__ATOMIC_RELEASE, "agent"); grid.sync(); \
    __builtin_amdgcn_fence(__ATOMIC_ACQUIRE, "agent"); asm volatile("s_waitcnt vmcnt(0)" ::: "memory"); } while (0)
struct Args { const float* in[15]; float* out; unsigned char* ws; };

__global__ void __launch_bounds__(NTHREADS, 2) fwd_megakernel(Args a) {
    extern __shared__ __attribute__((aligned(16))) unsigned char lds_raw[];
    LAS unsigned char* lds = (LAS unsigned char*)lds_raw;
    cg::grid_group grid = cg::this_grid();
    const int G = gridDim.x, bx = blockIdx.x; const int vcu = (G % 8 == 0) ? (bx % 8) * (G / 8) + bx / 8 : bx;
    unsigned char* ws = a.ws;
    const float *x = a.in[0], *g_mix = a.in[1], *w_in = a.in[2], *b_gate = a.in[3], *g_cq = a.in[4], *w_q_up = a.in[5], *g_ckv = a.in[6], *w_kv_up = a.in[7],
                *w_o_a = a.in[8], *w_o_b = a.in[9], *w_out = a.in[10], *g_mlp = a.in[11], *w_ff1 = a.in[12], *w_ff2 = a.in[13], *g_final = a.in[14];
    float* out = a.out;
    float *ROWSS_Q = (float*)(ws + WS_ROWSS_Q), *ROWSS_KV = (float*)(ws + WS_ROWSS_KV), *ROWSS2 = (float*)(ws + WS_ROWSS2), *KMEAN = (float*)(ws + WS_KMEAN);
    bf16_t *WIN = (bf16_t*)(ws + WS_WIN), *WQUP = (bf16_t*)(ws + WS_WQUP), *WKVUP = (bf16_t*)(ws + WS_WKVUP), *WOA = (bf16_t*)(ws + WS_WOA), *WOB = (bf16_t*)(ws + WS_WOB),
           *WOUT = (bf16_t*)(ws + WS_WOUT), *WFF1 = (bf16_t*)(ws + WS_WFF1), *WFF2 = (bf16_t*)(ws + WS_WFF2);
    float *ROPE64 = (float*)(ws + WS_ROPE64), *ROPE32 = (float*)(ws + WS_ROPE32);
    bf16_t *XN = (bf16_t*)(ws + WS_XN), *OA = (bf16_t*)(ws + WS_OA), *OB = (bf16_t*)(ws + WS_OB), *X1B = (bf16_t*)(ws + WS_X1B);
    bf16_t *QA = (bf16_t*)(ws + WS_QA), *KA = (bf16_t*)(ws + WS_KA), *VA = (bf16_t*)(ws + WS_VA), *CQ = (bf16_t*)(ws + WS_CQ), *CKV = (bf16_t*)(ws + WS_CKV),
           *QB = (bf16_t*)(ws + WS_QB), *KB = (bf16_t*)(ws + WS_KB), *VB = (bf16_t*)(ws + WS_VB), *Z = (bf16_t*)(ws + WS_Z), *U = (bf16_t*)(ws + WS_U);
    bf16_t* GT = (bf16_t*)out;

    {
        int tid_ = threadIdx.x; asm volatile("" : "+v"(tid_)); const int tid = tid_, lane = tid & 63, wave = __builtin_amdgcn_readfirstlane(tid >> 6);
        const int gw = vcu * 8 + wave, NGW = G * 8;
        const int gt = bx * NTHREADS + tid, NGT = G * NTHREADS;
        for (int i = gt; i < (int)(WS_CTL_END / 4); i += NGT) ((float*)ws)[i] = 0.f;
        for (int i = gt; i < SEQ * 32; i += NGT) { const int pos = i >> 5, f = i & 31; const float inv = __builtin_amdgcn_exp2f(-(float)f * (13.287712379549449f / 32.f)); const float ang = (float)pos * inv;
            double rev = (double)ang * 0.15915494309189535; rev -= __builtin_rint(rev); const float fr = (float)rev;
            ROPE64[2 * i] = __builtin_amdgcn_cosf(fr); ROPE64[2 * i + 1] = __builtin_amdgcn_sinf(fr); }
        for (int i = gt; i < SEQ * 16; i += NGT) { const int pos = i >> 4, f = i & 15; const float inv = __builtin_amdgcn_exp2f(-(float)f * (13.287712379549449f / 16.f)); const float ang = (float)pos * inv;
            double rev = (double)ang * 0.15915494309189535; rev -= __builtin_rint(rev); const float fr = (float)rev;
            ROPE32[2 * i] = __builtin_amdgcn_cosf(fr); ROPE32[2 * i + 1] = __builtin_amdgcn_sinf(fr); }
        LAS float* scr = (LAS float*)(lds + wave * 16384);
        constexpr int I_IN = 16 * 136, I_QUP = 6 * 24, I_KVUP = 4 * 32, I_OA = 8 * 32, I_OUT = 16 * 32, I_FF1 = 16 * 128, I_FF2 = 64 * 32;
        constexpr int NITEMS = I_IN + I_QUP + I_KVUP + 2 * I_OA + I_OUT + I_FF1 + I_FF2;
        for (int it = gw; it < NITEMS; it += NGW) {
            int r = it;
            if (r < I_IN) { transpose_item(w_in, 1024, 4256, 136, WIN, nullptr, true, scr, r, lane); continue; } r -= I_IN;
            if (r < I_QUP) { transpose_item(w_q_up, 384, 768, 24, WQUP, g_cq, false, scr, r, lane); continue; } r -= I_QUP;
            if (r < I_KVUP) { transpose_item(w_kv_up, 256, 1024, 32, WKVUP, g_ckv, false, scr, r, lane); continue; } r -= I_KVUP;
            if (r < I_OA) { transpose_item(w_o_a, 512, 1024, 32, WOA, nullptr, false, scr, r, lane); continue; } r -= I_OA;
            if (r < I_OA) { transpose_item(w_o_b, 512, 1024, 32, WOB, nullptr, false, scr, r, lane); continue; } r -= I_OA;
            if (r < I_OUT) { transpose_item(w_out, 1024, 1024, 32, WOUT, nullptr, false, scr, r, lane); continue; } r -= I_OUT;
            if (r < I_FF1) { transpose_item(w_ff1, 1024, 4096, 128, WFF1, g_mlp, false, scr, r, lane); continue; } r -= I_FF1;
            transpose_item(w_ff2, 4096, 1024, 32, WFF2, nullptr, false, scr, r, lane);
        }
        f32x4 gm[4];
#pragma unroll
        for (int j = 0; j < 4; ++j) gm[j] = *((const f32x4*)g_mix + lane + 64 * j);
        for (int m = gw; m < M; m += NGW) {
            const f32x4* xr = (const f32x4*)(x + (size_t)m * DM) + lane; f32x4 v[4]; float s = 0.f;
#pragma unroll
            for (int j = 0; j < 4; ++j) { v[j] = xr[64 * j]; s += (v[j][0] * v[j][0] + v[j][1] * v[j][1]) + (v[j][2] * v[j][2] + v[j][3] * v[j][3]); }
            const float rs = rsqrtf(wave_sum(s) * (1.f / DM) + EPS);
#pragma unroll
            for (int j = 0; j < 4; ++j) st4(XN + (size_t)m * DM + 4 * (lane + 64 * j), v[j] * rs * gm[j]);
        }
    }
    GRID_SYNC();
#if defined(DBG_STOP)
    if (DBG_STOP == 0) { int tid_ = threadIdx.x; asm volatile("" : "+v"(tid_)); const size_t gt = (size_t)bx * NTHREADS + tid_, NGT = (size_t)G * NTHREADS;
        const bf16_t* s0_ = (DBG_STOP == 0) ? XN : (DBG_STOP == 1) ? QA : (DBG_STOP == 2) ? QB : (DBG_STOP == 3) ? OA : Z;
        const bf16_t* s1_ = (DBG_STOP == 0) ? XN : (DBG_STOP == 1) ? CQ : (DBG_STOP == 2) ? VB : (DBG_STOP == 3) ? OB : Z;
        GRID_SYNC();
        for (size_t i = gt; i < (size_t)M * 512; i += NGT) { out[i] = bf2f(s0_[i]); out[(size_t)M * 512 + i] = bf2f(s1_[i]); }
        return; }
#endif
    { pg8::Gemm g{XN, WIN, M, NIN, 1024}; pg8::StaticOrder S; S.init(M, NIN, G, bx);
      EpiProj E{QA, KA, VA, CQ, CKV, KB, GT, ROWSS_Q, ROWSS_KV, KMEAN, ROPE64, ROPE32, b_gate};
      pg8::gemm_phase<EpiProj, pg8::StaticOrder, true, true>(lds, g, S, E); }
    GRID_SYNC();
#if defined(DBG_STOP)
    if (DBG_STOP == 1) { int tid_ = threadIdx.x; asm volatile("" : "+v"(tid_)); const size_t gt = (size_t)bx * NTHREADS + tid_, NGT = (size_t)G * NTHREADS;
        const bf16_t* s0_ = (DBG_STOP == 0) ? XN : (DBG_STOP == 1) ? QA : (DBG_STOP == 2) ? QB : (DBG_STOP == 3) ? OA : Z;
        const bf16_t* s1_ = (DBG_STOP == 0) ? XN : (DBG_STOP == 1) ? CQ : (DBG_STOP == 2) ? VB : (DBG_STOP == 3) ? OB : Z;
        GRID_SYNC();
        for (size_t i = gt; i < (size_t)M * 512; i += NGT) { out[i] = bf2f(s0_[i]); out[(size_t)M * 512 + i] = bf2f(s1_[i]); }
        return; }
#endif
    { pg8::Gemm g{CQ, WQUP, M, 768, 384}; pg8::StaticOrder S; S.init(M, 768, G, bx); EpiQup E{QB, ROWSS_Q, ROPE32};
      pg8::gemm_phase<EpiQup, pg8::StaticOrder, true, true>(lds, g, S, E); }
    __syncthreads();
    { pg8::Gemm g{CKV, WKVUP, M, 1024, 256}; pg8::StaticOrder S; S.init(M, 1024, G, bx); EpiKVup E{KB, VB, ROWSS_KV};
      pg8::gemm_phase<EpiKVup, pg8::StaticOrder, true, true>(lds, g, S, E); }
    GRID_SYNC();
#if defined(DBG_STOP)
    if (DBG_STOP == 2) { int tid_ = threadIdx.x; asm volatile("" : "+v"(tid_)); const size_t gt = (size_t)bx * NTHREADS + tid_, NGT = (size_t)G * NTHREADS;
        const bf16_t* s0_ = (DBG_STOP == 0) ? XN : (DBG_STOP == 1) ? QA : (DBG_STOP == 2) ? QB : (DBG_STOP == 3) ? OA : Z;
        const bf16_t* s1_ = (DBG_STOP == 0) ? XN : (DBG_STOP == 1) ? CQ : (DBG_STOP == 2) ? VB : (DBG_STOP == 3) ? OB : Z;
        GRID_SYNC();
        for (size_t i = gt; i < (size_t)M * 512; i += NGT) { out[i] = bf2f(s0_[i]); out[(size_t)M * 512 + i] = bf2f(s1_[i]); }
        return; }
#endif
    for (int p = vcu; p < 512; p += G) {
        const int kind = p >> 8, bh = (p & 255) >> 4, s = p & 15, b = bh >> 3, h = bh & 7;
        if (kind == 0) { attn_unit<96, false>(b, h, 31 - s, QB, KB, VB, OB, nullptr, lds); attn_unit<96, false>(b, h, s, QB, KB, VB, OB, nullptr, lds); }
        else           { attn_unit<64, true>(b, h, 31 - s, QA, KA, VA, OA, KMEAN, lds); attn_unit<64, true>(b, h, s, QA, KA, VA, OA, KMEAN, lds); }
    }
    GRID_SYNC();
#if defined(DBG_STOP)
    if (DBG_STOP == 3) { int tid_ = threadIdx.x; asm volatile("" : "+v"(tid_)); const size_t gt = (size_t)bx * NTHREADS + tid_, NGT = (size_t)G * NTHREADS;
        const bf16_t* s0_ = (DBG_STOP == 0) ? XN : (DBG_STOP == 1) ? QA : (DBG_STOP == 2) ? QB : (DBG_STOP == 3) ? OA : Z;
        const bf16_t* s1_ = (DBG_STOP == 0) ? XN : (DBG_STOP == 1) ? CQ : (DBG_STOP == 2) ? VB : (DBG_STOP == 3) ? OB : Z;
        GRID_SYNC();
        for (size_t i = gt; i < (size_t)M * 512; i += NGT) { out[i] = bf2f(s0_[i]); out[(size_t)M * 512 + i] = bf2f(s1_[i]); }
        return; }
#endif
    { pg8::Gemm g{OA, WOA, M, 1024, 512}; pg8::StaticOrder S; S.init(M, 1024, G, bx); EpiGate<false> E{Z, GT};
      pg8::gemm_phase<EpiGate<false>, pg8::StaticOrder, true, true>(lds, g, S, E); }
    __syncthreads();
    { pg8::Gemm g{OB, WOB, M, 1024, 512}; pg8::StaticOrder S; S.init(M, 1024, G, bx); EpiGate<true> E{Z, GT + (size_t)M * 1024};
      pg8::gemm_phase<EpiGate<true>, pg8::StaticOrder, true, true>(lds, g, S, E); }
    GRID_SYNC();
#if defined(DBG_STOP)
    if (DBG_STOP == 4) { int tid_ = threadIdx.x; asm volatile("" : "+v"(tid_)); const size_t gt = (size_t)bx * NTHREADS + tid_, NGT = (size_t)G * NTHREADS;
        const bf16_t* s0_ = (DBG_STOP == 0) ? XN : (DBG_STOP == 1) ? QA : (DBG_STOP == 2) ? QB : (DBG_STOP == 3) ? OA : Z;
        const bf16_t* s1_ = (DBG_STOP == 0) ? XN : (DBG_STOP == 1) ? CQ : (DBG_STOP == 2) ? VB : (DBG_STOP == 3) ? OB : Z;
        GRID_SYNC();
        for (size_t i = gt; i < (size_t)M * 512; i += NGT) { out[i] = bf2f(s0_[i]); out[(size_t)M * 512 + i] = bf2f(s1_[i]); }
        return; }
#endif
    { pg8::Gemm g{Z, WOUT, M, 1024, 1024}; pg8::StaticOrder S; S.init(M, 1024, G, bx); EpiOut E{x, out, X1B, ROWSS2};
      pg8::gemm_phase<EpiOut, pg8::StaticOrder, true, true>(lds, g, S, E); }
    GRID_SYNC();
    { pg8::Gemm g{X1B, WFF1, M, FF, 1024}; pg8::StaticOrder S; S.init(M, FF, G, bx); EpiFF1 E{U, ROWSS2};
      pg8::gemm_phase<EpiFF1, pg8::StaticOrder, true, true>(lds, g, S, E); }
    GRID_SYNC();
    { pg8::Gemm g{U, WFF2, M, 1024, FF}; pg8::StaticOrder S; S.init(M, 1024, G, bx); EpiFF2 E{out};
      pg8::gemm_phase<EpiFF2, pg8::StaticOrder, true, true>(lds, g, S, E); }
    GRID_SYNC();
    {
        int tid_ = threadIdx.x; asm volatile("" : "+v"(tid_)); const int tid = tid_, lane = tid & 63, wave = __builtin_amdgcn_readfirstlane(tid >> 6);
        const int gw = vcu * 8 + wave, NGW = G * 8;
        f32x4 gf[4];
#pragma unroll
        for (int j = 0; j < 4; ++j) gf[j] = *((const f32x4*)g_final + lane + 64 * j);
        for (int m = gw; m < M; m += NGW) {
            f32x4* xr = (f32x4*)(out + (size_t)m * DM) + lane; f32x4 v[4]; float s = 0.f;
#pragma unroll
            for (int j = 0; j < 4; ++j) { v[j] = xr[64 * j]; s += (v[j][0] * v[j][0] + v[j][1] * v[j][1]) + (v[j][2] * v[j][2] + v[j][3] * v[j][3]); }
            const float rs = rsqrtf(wave_sum(s) * (1.f / DM) + EPS);
#pragma unroll
            for (int j = 0; j < 4; ++j) xr[64 * j] = v[j] * rs * gf[j];
        }
    }
}

extern "C" void kernel_launch(void* const* d_in, const int* in_sizes, int n_in, void* d_out, int out_size, void* d_ws, size_t ws_size, hipStream_t stream) {
    static int grid = 0;
    if (grid == 0) {
        if (n_in != 15 || out_size != M * DM || ws_size < WS_END) { fprintf(stderr, "kernel_launch: unexpected shapes (n_in %d out %d ws %zu)\n", n_in, out_size, ws_size); grid = -1; return; }
        int dev = 0, cus = 0, per_cu = 0;
        hipGetDevice(&dev); hipDeviceGetAttribute(&cus, hipDeviceAttributeMultiprocessorCount, dev);
        if (hipFuncSetAttribute((const void*)fwd_megakernel, hipFuncAttributeMaxDynamicSharedMemorySize, LDS_BYTES) != hipSuccess) { fprintf(stderr, "kernel_launch: hipFuncSetAttribute failed\n"); grid = -1; return; }
        if (hipOccupancyMaxActiveBlocksPerMultiprocessor(&per_cu, (const void*)fwd_megakernel, NTHREADS, LDS_BYTES) != hipSuccess || per_cu < 1) { fprintf(stderr, "kernel_launch: occupancy query gave %d\n", per_cu); per_cu = 1; }
        (void)hipGetLastError();
        grid = cus * per_cu;
    }
    if (grid < 0) return;
    Args a{};
    for (int i = 0; i < 15; ++i) a.in[i] = (const float*)d_in[i];
    a.out = (float*)d_out; a.ws = (unsigned char*)d_ws;
    void* args[] = {&a};
    hipError_t e = hipLaunchCooperativeKernel((const void*)fwd_megakernel, dim3(grid), dim3(NTHREADS), args, LDS_BYTES, stream);
    if (e != hipSuccess) fprintf(stderr, "cooperative launch failed: %s (grid %d)\n", hipGetErrorString(e), grid);
}
```

```cpp
#include <hip/hip_runtime.h>
#include <hip/hip_cooperative_groups.h>
#include <cstdio>
#include <cstdint>
namespace cg = cooperative_groups;
namespace pg8 {
#define PG8_LAS __attribute__((address_space(3)))
typedef unsigned short bf16_t;
typedef short bf16x8 __attribute__((ext_vector_type(8)));
typedef float f32x4 __attribute__((ext_vector_type(4)));
typedef unsigned u32x4 __attribute__((ext_vector_type(4)));
constexpr int BM = 256, BK = 64, HALF = 128, HTB = HALF * BK * 2  , STAGE_BYTES = 8 * HTB, NXCD = 8, WGM = 8;

__host__ __device__ __forceinline__ int lds_byte(int r, int c) { const int st = (r >> 4) * 2 + (c >> 5), rr = r & 15, cc = c & 31, ob = rr * 64 + cc * 2; return st * 1024 + (ob ^ (((ob >> 9) & 1) << 5)); }
__host__ __device__ __forceinline__ void stage_rc(int b, int& R, int& C) { const int st = b / 1024, sb = b % 1024, swz = sb ^ (((sb >> 9) & 1) << 5); R = (st >> 1) * 16 + swz / 64; C = (st & 1) * 32 + (swz % 64) / 2; }
__host__ __device__ __forceinline__ int perm32(int rho) { const int n = rho >> 4, i = rho & 15; return 8 * (i >> 2) + 4 * n + (i & 3); }

struct Unit { int pm, pn; };
struct Gemm { const bf16_t* A; const bf16_t* Bt; int M, N, K; };

struct StaticOrder {
    int nM, nN, nwg, G, c;
    __host__ __device__ void init(int M, int N, int G_, int c_) { nM = M / BM; nN = N / BM; nwg = nM * nN; G = G_; c = c_; }
    __host__ __device__ bool next(int i, Unit& u) const {
        const long L = (long)i * G + c; if (L >= nwg) return false;
        int wgid = (int)L; { const int q = nwg / NXCD, r = nwg % NXCD, xcd = wgid % NXCD, off = wgid / NXCD; wgid = (xcd < r ? xcd * (q + 1) : r * (q + 1) + (xcd - r) * q) + off; }
        const int nig = WGM * nN, gid = wgid / nig, fm = gid * WGM, gsz = (nM - fm) < WGM ? (nM - fm) : WGM;
        u.pm = fm + ((wgid % nig) % gsz); u.pn = (wgid % nig) / gsz; return true;
    }
    __device__ __forceinline__ void a_ready(const Unit&) const {}
    __device__ __forceinline__ void done(const Unit&) const {}
};

__device__ __forceinline__ unsigned cvt_pk_bf16(float lo, float hi) { unsigned r; asm volatile("v_cvt_pk_bf16_f32 %0, %1, %2" : "=v"(r) : "v"(lo), "v"(hi)); return r; }
typedef float f32x2 __attribute__((ext_vector_type(2)));
template <class Epi, class Sched, bool ALIGN_EPI = false, bool SP2 = false>
__device__ __forceinline__ void gemm_phase(PG8_LAS unsigned char* lds, const Gemm g, const Sched& S, const Epi& E) {
    int tid_ = threadIdx.x; asm volatile("" : "+v"(tid_));
    const int tid = tid_, wid = __builtin_amdgcn_readfirstlane(tid >> 6), lane = tid & 63, wr = wid >> 2, wc = wid & 3, fr = lane & 15, fq = lane >> 4;
    const int K = g.K, nt = K / BK;
    unsigned voffA[2], voffB[2];
#pragma unroll
    for (int i = 0; i < 2; ++i) { int R, C; stage_rc(tid * 16 + i * 8192, R, C); const int Rb = Epi::PERM ? ((R & ~31) + perm32(R & 31)) : R;
        voffA[i] = (unsigned)(R * K + C) * 2u; voffB[i] = (unsigned)(Rb * K + C) * 2u; }
    const size_t kstep = (size_t)(BK * 2);
    const size_t hstep = (size_t)HALF * K * 2;
    const size_t tstep = 2 * hstep;
    const unsigned ldsw = (unsigned)wid * 1024u;
    const int aoff = lds_byte(wr * 64 + fr, fq * 8), boff = lds_byte(wc * 32 + fr, fq * 8);
#define PG8_SA(b, h) (((b) * 2 + (h)) * HTB)
#define PG8_SB(b, h) ((4 + (b) * 2 + (h)) * HTB)
#define PG8_STAGE(bufoff, gbase, voff) do { _Pragma("unroll") for (int _i = 0; _i < 2; ++_i) \
        __builtin_amdgcn_global_load_lds((const unsigned*)((const char*)(gbase) + (voff)[_i]), (PG8_LAS unsigned*)(lds + (bufoff) + ldsw + _i * 8192), 16, 0, 0); } while (0)
#define PG8_LDA(dst, b, h) do { _Pragma("unroll") for (int m = 0; m < 4; ++m) _Pragma("unroll") for (int k = 0; k < 2; ++k) dst[m][k] = *(const PG8_LAS bf16x8*)(lds + PG8_SA(b, h) + aoff + m * 2048 + k * 1024); } while (0)
#define PG8_LDB(dst, b, h) do { _Pragma("unroll") for (int n = 0; n < 2; ++n) _Pragma("unroll") for (int k = 0; k < 2; ++k) dst[n][k] = *(const PG8_LAS bf16x8*)(lds + PG8_SB(b, h) + boff + n * 2048 + k * 1024); } while (0)
#define PG8_MMA(ai, bj, At, Bt) do { __builtin_amdgcn_s_setprio(1); _Pragma("unroll") for (int m = 0; m < 4; ++m) _Pragma("unroll") for (int n = 0; n < 2; ++n) _Pragma("unroll") for (int k = 0; k < 2; ++k) \
        acc[ai][bj][m][n] = __builtin_amdgcn_mfma_f32_16x16x32_bf16(Bt[n][k], At[m][k], acc[ai][bj][m][n], 0, 0, 0); __builtin_amdgcn_s_setprio(0); } while (0)
#define PG8_WAIT_V(n) asm volatile("s_waitcnt vmcnt(" #n ")" ::: "memory")
#define PG8_WAIT_L(n) asm volatile("s_waitcnt lgkmcnt(" #n ")" ::: "memory")
#define PG8_BAR __builtin_amdgcn_s_barrier()
#define PG8_SCHED __builtin_amdgcn_sched_barrier(0)
    Unit cur, nxt; int ui = 0;
    if (!S.next(0, cur)) return;
    f32x4 acc[2][2][4][2];
#pragma unroll
    for (int a = 0; a < 2; ++a)
#pragma unroll
        for (int b = 0; b < 2; ++b)
#pragma unroll
            for (int m = 0; m < 4; ++m)
#pragma unroll
                for (int n = 0; n < 2; ++n) acc[a][b][m][n] = (f32x4){0.f, 0.f, 0.f, 0.f};
    bf16x8 At[4][2], B0[2][2], B1[2][2];
    const char* cA = (const char*)g.A + (size_t)cur.pm * tstep; const char* cB = (const char*)g.Bt + (size_t)cur.pn * tstep;
    S.a_ready(cur);
    if constexpr (SP2) {
        PG8_STAGE(PG8_SB(0, 0), cB, voffB); PG8_STAGE(PG8_SB(0, 1), cB + hstep, voffB); PG8_STAGE(PG8_SA(0, 0), cA, voffA); PG8_STAGE(PG8_SA(0, 1), cA + hstep, voffA);
        if (wr == 1) PG8_BAR;
        PG8_WAIT_V(2); PG8_BAR;
        PG8_STAGE(PG8_SB(1, 0), cB + kstep, voffB); PG8_STAGE(PG8_SA(1, 0), cA + kstep, voffA); PG8_STAGE(PG8_SB(1, 1), cB + hstep + kstep, voffB);
        PG8_WAIT_V(6); PG8_BAR;
    } else {
        PG8_STAGE(PG8_SB(0, 0), cB, voffB); PG8_STAGE(PG8_SA(0, 0), cA, voffA); PG8_STAGE(PG8_SB(0, 1), cB + hstep, voffB); PG8_STAGE(PG8_SA(0, 1), cA + hstep, voffA);
        if (wr == 1) PG8_BAR;
        PG8_WAIT_V(4); PG8_BAR;
        PG8_STAGE(PG8_SB(1, 0), cB + kstep, voffB); PG8_STAGE(PG8_SA(1, 0), cA + kstep, voffA); PG8_STAGE(PG8_SB(1, 1), cB + hstep + kstep, voffB);
        PG8_WAIT_V(6); PG8_BAR;
    }
    for (;;) {
        const bool has_next = S.next(ui + 1, nxt);
        const char* nA = has_next ? (const char*)g.A + (size_t)nxt.pm * tstep : cA; const char* nB = has_next ? (const char*)g.Bt + (size_t)nxt.pn * tstep : cB;
        for (int t = 0; t < nt; t += 2) {
            const bool last = (t == nt - 2);
            const char* a1 = cA + (size_t)(t + 1) * kstep;
            const char* a2 = last ? nA : cA + (size_t)(t + 2) * kstep; const char* b2 = last ? nB : cB + (size_t)(t + 2) * kstep;
            const char* a3 = a2 + kstep; const char* b3 = b2 + kstep;
            if (last && has_next) S.a_ready(nxt);
            if constexpr (SP2) {
            PG8_LDB(B0, 0, 0); PG8_LDB(B1, 0, 1); PG8_SCHED; PG8_LDA(At, 0, 0); PG8_STAGE(PG8_SA(1, 1), a1 + hstep, voffA);
            PG8_WAIT_V(8); PG8_WAIT_L(0); PG8_BAR; PG8_MMA(0, 0, At, B0); PG8_MMA(0, 1, At, B1); PG8_BAR; PG8_SCHED;
            PG8_LDA(At, 0, 1); PG8_STAGE(PG8_SB(0, 0), b2, voffB); PG8_STAGE(PG8_SB(0, 1), b2 + hstep, voffB); PG8_STAGE(PG8_SA(0, 0), a2, voffA);
            PG8_WAIT_V(8); PG8_WAIT_L(0); PG8_BAR; PG8_MMA(1, 0, At, B0); PG8_MMA(1, 1, At, B1); PG8_BAR; PG8_SCHED;
            PG8_LDB(B0, 1, 0); PG8_LDB(B1, 1, 1); PG8_SCHED; PG8_LDA(At, 1, 0); PG8_STAGE(PG8_SA(0, 1), a2 + hstep, voffA);
            PG8_WAIT_V(8); PG8_WAIT_L(0); PG8_BAR; PG8_MMA(0, 0, At, B0); PG8_MMA(0, 1, At, B1); PG8_BAR; PG8_SCHED;
            PG8_LDA(At, 1, 1); PG8_STAGE(PG8_SB(1, 0), b3, voffB); PG8_STAGE(PG8_SB(1, 1), b3 + hstep, voffB); PG8_STAGE(PG8_SA(1, 0), a3, voffA);
            PG8_WAIT_V(8); PG8_WAIT_L(0); PG8_BAR; PG8_MMA(1, 0, At, B0); PG8_MMA(1, 1, At, B1); PG8_BAR; PG8_SCHED;
            } else {
            PG8_LDB(B0, 0, 0); PG8_SCHED; PG8_LDA(At, 0, 0); PG8_STAGE(PG8_SA(1, 1), a1 + hstep, voffA);
            PG8_WAIT_L(8); PG8_BAR; PG8_WAIT_L(0); PG8_MMA(0, 0, At, B0); PG8_BAR; PG8_SCHED;
            PG8_LDB(B1, 0, 1); PG8_STAGE(PG8_SB(0, 0), b2, voffB);
            PG8_BAR; PG8_WAIT_L(0); PG8_MMA(0, 1, At, B1); PG8_BAR;
            PG8_LDA(At, 0, 1); PG8_STAGE(PG8_SA(0, 0), a2, voffA);
            PG8_BAR; PG8_WAIT_L(0); PG8_MMA(1, 0, At, B0); PG8_BAR; PG8_SCHED;
            PG8_STAGE(PG8_SB(0, 1), b2 + hstep, voffB);
            PG8_WAIT_V(6); PG8_BAR; PG8_MMA(1, 1, At, B1); PG8_BAR;
            PG8_LDB(B0, 1, 0); PG8_SCHED; PG8_LDA(At, 1, 0); PG8_STAGE(PG8_SA(0, 1), a2 + hstep, voffA);
            PG8_WAIT_L(8); PG8_BAR; PG8_WAIT_L(0); PG8_MMA(0, 0, At, B0); PG8_BAR; PG8_SCHED;
            PG8_LDB(B1, 1, 1); PG8_STAGE(PG8_SB(1, 0), b3, voffB);
            PG8_BAR; PG8_WAIT_L(0); PG8_MMA(0, 1, At, B1); PG8_BAR;
            PG8_LDA(At, 1, 1); PG8_STAGE(PG8_SA(1, 0), a3, voffA);
            PG8_BAR; PG8_WAIT_L(0); PG8_MMA(1, 0, At, B0); PG8_BAR; PG8_SCHED;
            PG8_STAGE(PG8_SB(1, 1), b3 + hstep, voffB);
            PG8_WAIT_V(6); PG8_BAR; PG8_MMA(1, 1, At, B1); PG8_BAR;
            }
        }
        if constexpr (ALIGN_EPI) { if (wr == 0) PG8_BAR; }
        if constexpr (!Epi::AFTER_DRAIN) { E(acc, cur, wr, wc, fr, fq); S.done(cur); }
        if (!has_next) break;
#pragma unroll
        for (int a = 0; a < 2; ++a)
#pragma unroll
            for (int b = 0; b < 2; ++b)
#pragma unroll
                for (int m = 0; m < 4; ++m)
#pragma unroll
                    for (int n = 0; n < 2; ++n) acc[a][b][m][n] = (f32x4){0.f, 0.f, 0.f, 0.f};
        cur = nxt; cA = nA; cB = nB; ++ui;
        if constexpr (ALIGN_EPI) { if (wr == 1) PG8_BAR; }
    }
    PG8_WAIT_V(0);
    if constexpr (!ALIGN_EPI) { if (wr == 0) PG8_BAR; }
    PG8_BAR;
    if constexpr (Epi::AFTER_DRAIN) { E.fused(acc, cur, wr, wc, fr, fq, lds, wid, lane); S.done(cur); }
#undef PG8_SA
#undef PG8_SB
#undef PG8_STAGE
#undef PG8_LDA
#undef PG8_LDB
#undef PG8_MMA
#undef PG8_WAIT_V
#undef PG8_WAIT_L
#undef PG8_BAR
#undef PG8_SCHED
}
}

#define LAS __attribute__((address_space(3)))
typedef unsigned short bf16_t;
typedef short bf16x8 __attribute__((ext_vector_type(8)));
typedef float f32x4 __attribute__((ext_vector_type(4)));
typedef float f32x16 __attribute__((ext_vector_type(16)));
typedef unsigned u32x2 __attribute__((ext_vector_type(2)));
typedef unsigned u32x4 __attribute__((ext_vector_type(4)));

#define XB_TMO      128
#define XB_XCNT(j)  (256  + 64 * (j))
#define XB_XSUB(j)  (1280 + 64 * (j))
#define XB_XGEN(j)  (2304 + 64 * (j))
#define XB_TOP      3328
#define XB_TOPGEN   3392
#define XCD_BAR_WORDS 3456
#define XB_SPIN_CAP (1u << 18)

__device__ __forceinline__ unsigned xb_ld(unsigned* p)              { return __hip_atomic_load(p, __ATOMIC_RELAXED, __HIP_MEMORY_SCOPE_AGENT); }
__device__ __forceinline__ unsigned xb_add(unsigned* p, unsigned v) { return __hip_atomic_fetch_add(p, v, __ATOMIC_RELAXED, __HIP_MEMORY_SCOPE_AGENT); }
__device__ __forceinline__ unsigned xb_xcc_id() { return (unsigned)__builtin_amdgcn_s_getreg((3 << 11) | 20) & 0xFu; }
#define XB_SPIN(cond, bar) do { unsigned _sp = 0; while (cond) { __builtin_amdgcn_s_sleep(1); \
    if ((++_sp & 255u) == 0u) { if (xb_ld(&(bar)[XB_TMO])) break; if (_sp > XB_SPIN_CAP) { atomicAdd(&(bar)[XB_TMO], 1u); break; } } } } while (0)

struct XcdBarrier {
    unsigned* bar; unsigned x;
    volatile LAS unsigned* st;
};

__device__ __forceinline__ XcdBarrier xcd_barrier_post(unsigned* bar, volatile LAS unsigned* st) {
    XcdBarrier b; b.bar = bar; b.x = xb_xcc_id(); b.st = st;
    if (threadIdx.x == 0) (void)xb_add(&bar[XB_XCNT(b.x)], 1u);
    return b;
}
__device__ __forceinline__ void xcd_barrier_complete(unsigned* bar, unsigned x, unsigned& nloc, unsigned& nx) {
    const unsigned G = gridDim.x * gridDim.y * gridDim.z;
    unsigned sum, cnt, mine, sp = 0u;
    for (;;) {
        sum = 0u; cnt = 0u; mine = 0u;
#pragma unroll
        for (unsigned j = 0; j < 16; ++j) { const unsigned c = xb_ld(&bar[XB_XCNT(j)]); sum += c; cnt += (c > 0u) ? 1u : 0u; mine = (j == x) ? c : mine; }
        if (sum == G) break;
        __builtin_amdgcn_s_sleep(1);
        if ((++sp & 255u) == 0u) { if (xb_ld(&bar[XB_TMO])) break; if (sp > XB_SPIN_CAP) { atomicAdd(&bar[XB_TMO], 1u); break; } }
    }
    nloc = mine > 0u ? mine : 1u; nx = cnt > 0u ? cnt : 1u;
}

__device__ __forceinline__ void xcd_barrier(const XcdBarrier& b) {
    asm volatile("s_waitcnt vmcnt(0)" ::: "memory");
    __syncthreads();
    if (threadIdx.x == 0) {
        unsigned* bar = b.bar;
        __builtin_amdgcn_s_waitcnt(0);
        unsigned nloc = b.st[0], nx = b.st[1];
        if (nloc == 0u) { xcd_barrier_complete(bar, b.x, nloc, nx); b.st[0] = nloc; b.st[1] = nx; }
        const unsigned old = xb_add(&bar[XB_XSUB(b.x)], 1u);
        const unsigned gen = old / nloc;
        if (old + 1u == (gen + 1u) * nloc) {
            __builtin_amdgcn_fence(__ATOMIC_RELEASE, "agent");
            asm volatile("s_waitcnt vmcnt(0)" ::: "memory");
            const unsigned og = xb_add(&bar[XB_TOP], 1u);
            const unsigned tg = og / nx;
            if (og + 1u == (tg + 1u) * nx) xb_add(&bar[XB_TOPGEN], 1u);
            else XB_SPIN(xb_ld(&bar[XB_TOPGEN]) == tg, bar);
            __builtin_amdgcn_fence(__ATOMIC_ACQUIRE, "agent");
            xb_add(&bar[XB_XGEN(b.x)], 1u);
            asm volatile("s_waitcnt vmcnt(0)" ::: "memory");
        } else {
            XB_SPIN(xb_ld(&bar[XB_XGEN(b.x)]) == gen, bar);
            __builtin_amdgcn_fence(__ATOMIC_ACQUIRE, "agent");
            asm volatile("s_waitcnt vmcnt(0)" ::: "memory");
        }
    }
    __syncthreads();
}

constexpr int SEQ = 8192, NBATCH = 2, M = NBATCH * SEQ, DM = 1024, FF = 4096;
constexpr int NIN = 4352;
constexpr float EPS = 1e-6f;
constexpr float LOG2E = 1.4426950408889634f;
constexpr float C_A = 0.125f * LOG2E;
constexpr float C_B = 0.10206207261596575f * LOG2E;
constexpr size_t MiB = 1u << 20;
constexpr size_t WS_BAR = 512 * 1024, WS_BAR_BYTES = 16384;
constexpr size_t WS_ROWSS_Q = 0, WS_ROWSS_KV = 65536, WS_ROWSS2 = 131072, WS_KMEAN = 196608, WS_CTL_END = 327680;
constexpr size_t WS_WIN = 1 * MiB, WS_WQUP = 10 * MiB, WS_WKVUP = 11 * MiB, WS_WOA = 12 * MiB, WS_WOB = 13 * MiB, WS_WOUT = 14 * MiB, WS_WFF1 = 16 * MiB, WS_WFF2 = 24 * MiB;
constexpr size_t WS_ROPE64 = 32 * MiB, WS_ROPE32 = 34 * MiB;
constexpr size_t WS_XN = 36 * MiB, WS_OA = 36 * MiB, WS_OB = 52 * MiB, WS_X1B = 36 * MiB;
constexpr size_t WS_QA = 68 * MiB, WS_KA = 84 * MiB, WS_VA = 100 * MiB, WS_CQ = 116 * MiB, WS_CKV = 128 * MiB, WS_QB = 138 * MiB, WS_KB = 162 * MiB, WS_VB = 186 * MiB;
constexpr size_t WS_Z = 68 * MiB, WS_U = 68 * MiB, WS_END = 202 * MiB;
constexpr int LDS_BYTES = 147456;
constexpr int NTHREADS = 512;

typedef float f32x2_t __attribute__((ext_vector_type(2))); typedef __bf16 bf16x2_t __attribute__((ext_vector_type(2)));
__device__ __forceinline__ unsigned cvtpk(float lo, float hi) { f32x2_t v = {lo, hi}; bf16x2_t b = __builtin_convertvector(v, bf16x2_t); return __builtin_bit_cast(unsigned, b); }
__device__ __forceinline__ void st4(bf16_t* p, f32x4 v) { u32x2 w; w.x = cvtpk(v[0], v[1]); w.y = cvtpk(v[2], v[3]); *(u32x2*)p = w; }
__device__ __forceinline__ float bf2f(unsigned short s) { return __uint_as_float(((unsigned)s) << 16); }
__device__ __forceinline__ f32x4 ld4bf(const bf16_t* p) { const u32x2 w = *(const u32x2*)p; return (f32x4){__uint_as_float(w.x << 16), __uint_as_float(w.x & 0xffff0000u), __uint_as_float(w.y << 16), __uint_as_float(w.y & 0xffff0000u)}; }
__device__ __forceinline__ float wave_sum(float v) {
#pragma unroll
    for (int o = 1; o < 64; o <<= 1) v += __shfl_xor(v, o);
    return v;
}

#define EPI_ROWS(ai, m) for (int ai = 0; ai < 2; ++ai) _Pragma("unroll") for (int m = 0; m < 4; ++m)

struct EpiProj {
    static constexpr bool PERM = false, AFTER_DRAIN = false;
    bf16_t *QA, *KA, *VA, *CQ, *CKV, *KB, *G; float *ROWSS_Q, *ROWSS_KV, *KMEAN; const float *ROPE64, *ROPE32, *b_gate;
    __device__ __forceinline__ void operator()(const f32x4 (&acc)[2][2][4][2], const pg8::Unit& u, int wr, int wc, int fr, int fq) const {
        const int pn = u.pn; const int row0 = u.pm * 256 + wr * 64 + fr; const int cl = wc * 32 + 4 * fq;
        if (pn < 4) {
            bf16_t* dst = pn < 2 ? QA : KA; const int cbase = (pn & 1) * 256; const float sc = pn < 2 ? C_A : 1.f; const int fi = 16 * (wc & 1) + 4 * fq;
            f32x4 ks[2][2];
#pragma unroll
            for (int bj = 0; bj < 2; ++bj) { ks[bj][0] = (f32x4){0.f, 0.f, 0.f, 0.f}; ks[bj][1] = (f32x4){0.f, 0.f, 0.f, 0.f}; }
#pragma unroll
            EPI_ROWS(ai, m) {
                const int row = row0 + 128 * ai + 16 * m; const int pos = row & (SEQ - 1);
                const f32x4* rp = (const f32x4*)(ROPE64 + ((size_t)pos * 32 + fi) * 2); const f32x4 r01 = rp[0], r23 = rp[1];
                const f32x4 c = (f32x4){r01[0], r01[2], r23[0], r23[2]}, s = (f32x4){r01[1], r01[3], r23[1], r23[3]};
#pragma unroll
                for (int bj = 0; bj < 2; ++bj) {
                    const f32x4 x1 = acc[ai][bj][m][0], x2 = acc[ai][bj][m][1];
                    const f32x4 o1 = x1 * c - x2 * s, o2 = x2 * c + x1 * s;
                    ks[bj][0] += o1; ks[bj][1] += o2;
                    bf16_t* p = dst + (size_t)row * 512 + cbase + 128 * bj + cl;
                    st4(p, o1 * sc); st4(p + 16, o2 * sc);
                }
            }
            if (pn >= 2) {
#pragma unroll
                for (int bj = 0; bj < 2; ++bj)
#pragma unroll
                    for (int n = 0; n < 2; ++n)
#pragma unroll
                        for (int j = 0; j < 4; ++j) { float v = ks[bj][n][j]; v += __shfl_xor(v, 1); v += __shfl_xor(v, 2); v += __shfl_xor(v, 4); v += __shfl_xor(v, 8);
                            if (fr == 0) unsafeAtomicAdd(KMEAN + (size_t)u.pm * 512 + cbase + 128 * bj + cl + 16 * n + j, v * (1.f / 256.f)); }
            }
        } else if (pn < 6) {
            const int cbase = (pn - 4) * 256;
#pragma unroll
            EPI_ROWS(ai, m) { const int row = row0 + 128 * ai + 16 * m;
#pragma unroll
                for (int bj = 0; bj < 2; ++bj)
#pragma unroll
                    for (int n = 0; n < 2; ++n) st4(VA + (size_t)row * 512 + cbase + 128 * bj + cl + 16 * n, acc[ai][bj][m][n]); }
        } else if (pn < 9) {
#pragma unroll
            EPI_ROWS(ai, m) { const int row = row0 + 128 * ai + 16 * m; float sq = 0.f, skv = 0.f;
#pragma unroll
                for (int bj = 0; bj < 2; ++bj) {
                    const f32x4 v0 = acc[ai][bj][m][0], v1 = acc[ai][bj][m][1];
                    const float ss = (v0[0] * v0[0] + v0[1] * v0[1]) + (v0[2] * v0[2] + v0[3] * v0[3]) + (v1[0] * v1[0] + v1[1] * v1[1]) + (v1[2] * v1[2] + v1[3] * v1[3]);
                    const int sel = (pn - 6) * 2 + bj;
                    if (sel < 3) { sq += ss; bf16_t* p = CQ + (size_t)row * 384 + 128 * sel + cl; st4(p, v0); st4(p + 16, v1); }
                    else if (sel < 5) { skv += ss; bf16_t* p = CKV + (size_t)row * 256 + 128 * (sel - 3) + cl; st4(p, v0); st4(p + 16, v1); }
                    else if (wc == 0) {
                        const int pos = row & (SEQ - 1);
                        const f32x4* rp = (const f32x4*)(ROPE32 + ((size_t)pos * 16 + 4 * fq) * 2); const f32x4 r01 = rp[0], r23 = rp[1];
                        const f32x4 c = (f32x4){r01[0], r01[2], r23[0], r23[2]}, s = (f32x4){r01[1], r01[3], r23[1], r23[3]};
                        const f32x4 o1 = v0 * c - v1 * s, o2 = v1 * c + v0 * s;
#pragma unroll
                        for (int h = 0; h < 8; ++h) { bf16_t* p = KB + (size_t)row * 768 + 96 * h + 64 + 4 * fq; st4(p, o1); st4(p + 16, o2); }
                    }
                }
                if (pn < 8) { sq += __shfl_xor(sq, 16); sq += __shfl_xor(sq, 32); if (fq == 0) unsafeAtomicAdd(ROWSS_Q + row, sq); }
                if (pn > 6) { skv += __shfl_xor(skv, 16); skv += __shfl_xor(skv, 32); if (fq == 0) unsafeAtomicAdd(ROWSS_KV + row, skv); }
            }
        } else {
            const int gbase = (pn - 9) * 256;
#pragma unroll
            for (int bj = 0; bj < 2; ++bj)
#pragma unroll
                for (int n = 0; n < 2; ++n) {
                    const int gc = gbase + 128 * bj + cl + 16 * n; const f32x4 bv = *(const f32x4*)(b_gate + gc);
                    bf16_t* dst = G + (size_t)(gc >> 10) * ((size_t)M * 1024) + (gc & 1023);
#pragma unroll
                    EPI_ROWS(ai, m) { const int row = row0 + 128 * ai + 16 * m; f32x4 v = acc[ai][bj][m][n] + bv;
#pragma unroll
                        for (int j = 0; j < 4; ++j) v[j] = __builtin_amdgcn_rcpf(1.f + __builtin_amdgcn_exp2f(-LOG2E * v[j]));
                        st4(dst + (size_t)row * 1024, v); }
                }
        }
    }
};
struct EpiQup {
    static constexpr bool PERM = false, AFTER_DRAIN = false;
    bf16_t* QB; const float *ROWSS_Q, *ROPE32;
    __device__ __forceinline__ void operator()(const f32x4 (&acc)[2][2][4][2], const pg8::Unit& u, int wr, int wc, int fr, int fq) const {
        const int row0 = u.pm * 256 + wr * 64 + fr;
#pragma unroll
        EPI_ROWS(ai, m) { const int row = row0 + 128 * ai + 16 * m; const float rs = rsqrtf(ROWSS_Q[row] * (1.f / 384.f) + EPS) * C_B; const int pos = row & (SEQ - 1);
#pragma unroll
            for (int bj = 0; bj < 2; ++bj) {
                const int grp = 8 * u.pn + 4 * bj + wc; const int part = grp % 3;
                f32x4 v0 = acc[ai][bj][m][0] * rs, v1 = acc[ai][bj][m][1] * rs;
                if (part == 2) {
                    const f32x4* rp = (const f32x4*)(ROPE32 + ((size_t)pos * 16 + 4 * fq) * 2); const f32x4 r01 = rp[0], r23 = rp[1];
                    const f32x4 c = (f32x4){r01[0], r01[2], r23[0], r23[2]}, s = (f32x4){r01[1], r01[3], r23[1], r23[3]};
                    const f32x4 o1 = v0 * c - v1 * s, o2 = v1 * c + v0 * s; v0 = o1; v1 = o2;
                }
                bf16_t* p = QB + (size_t)row * 768 + 32 * grp + 4 * fq; st4(p, v0); st4(p + 16, v1);
            } }
    }
};
struct EpiKVup {
    static constexpr bool PERM = false, AFTER_DRAIN = false;
    bf16_t *KB, *VB; const float* ROWSS_KV;
    __device__ __forceinline__ void operator()(const f32x4 (&acc)[2][2][4][2], const pg8::Unit& u, int wr, int wc, int fr, int fq) const {
        const int row0 = u.pm * 256 + wr * 64 + fr;
#pragma unroll
        EPI_ROWS(ai, m) { const int row = row0 + 128 * ai + 16 * m; const float rs = rsqrtf(ROWSS_KV[row] * (1.f / 256.f) + EPS);
#pragma unroll
            for (int bj = 0; bj < 2; ++bj) { const int head = 2 * u.pn + bj;
                bf16_t* p = (wc < 2) ? KB + (size_t)row * 768 + 96 * head + 32 * wc + 4 * fq : VB + (size_t)row * 512 + 64 * head + 32 * (wc - 2) + 4 * fq;
                st4(p, acc[ai][bj][m][0] * rs); st4(p + 16, acc[ai][bj][m][1] * rs); } }
    }
};
template <bool ADD> struct EpiGate {
    static constexpr bool PERM = false, AFTER_DRAIN = false;
    bf16_t* Z; const bf16_t* Gt;
    __device__ __forceinline__ void operator()(const f32x4 (&acc)[2][2][4][2], const pg8::Unit& u, int wr, int wc, int fr, int fq) const {
        const int row0 = u.pm * 256 + wr * 64 + fr; const int col0 = u.pn * 256 + wc * 32 + 4 * fq;
#pragma unroll
        EPI_ROWS(ai, m) { const size_t ro = (size_t)(row0 + 128 * ai + 16 * m) * 1024 + col0;
#pragma unroll
            for (int bj = 0; bj < 2; ++bj)
#pragma unroll
                for (int n = 0; n < 2; ++n) { const size_t o = ro + 128 * bj + 16 * n; f32x4 v = acc[ai][bj][m][n] * ld4bf(Gt + o); if (ADD) v += ld4bf(Z + o); st4(Z + o, v); } }
    }
};
struct EpiOut {
    static constexpr bool PERM = false, AFTER_DRAIN = false;
    const float* X; float* X1; bf16_t* X1B; float* ROWSS2;
    __device__ __forceinline__ void operator()(const f32x4 (&acc)[2][2][4][2], const pg8::Unit& u, int wr, int wc, int fr, int fq) const {
        const int row0 = u.pm * 256 + wr * 64 + fr; const int col0 = u.pn * 256 + wc * 32 + 4 * fq;
#pragma unroll
        EPI_ROWS(ai, m) { const int row = row0 + 128 * ai + 16 * m; const size_t ro = (size_t)row * 1024 + col0; float ss = 0.f;
#pragma unroll
            for (int bj = 0; bj < 2; ++bj)
#pragma unroll
                for (int n = 0; n < 2; ++n) { const size_t o = ro + 128 * bj + 16 * n; const f32x4 v = acc[ai][bj][m][n] + *(const f32x4*)(X + o);
                    ss += (v[0] * v[0] + v[1] * v[1]) + (v[2] * v[2] + v[3] * v[3]); *(f32x4*)(X1 + o) = v; st4(X1B + o, v); }
            ss += __shfl_xor(ss, 16); ss += __shfl_xor(ss, 32); if (fq == 0) unsafeAtomicAdd(ROWSS2 + row, ss); }
    }
};
struct EpiFF1 {
    static constexpr bool PERM = false, AFTER_DRAIN = false;
    bf16_t* U; const float* ROWSS2;
    __device__ __forceinline__ void operator()(const f32x4 (&acc)[2][2][4][2], const pg8::Unit& u, int wr, int wc, int fr, int fq) const {
        const int row0 = u.pm * 256 + wr * 64 + fr; const int col0 = u.pn * 256 + wc * 32 + 4 * fq;
#pragma unroll
        EPI_ROWS(ai, m) { const int row = row0 + 128 * ai + 16 * m; const float r2 = 1.f / (ROWSS2[row] * (1.f / 1024.f) + EPS);
#pragma unroll
            for (int bj = 0; bj < 2; ++bj)
#pragma unroll
                for (int n = 0; n < 2; ++n) { f32x4 v = acc[ai][bj][m][n];
#pragma unroll
                    for (int j = 0; j < 4; ++j) { const float t = fmaxf(v[j], 0.f); v[j] = t * t * r2; }
                    st4(U + (size_t)row * FF + col0 + 128 * bj + 16 * n, v); } }
    }
};
struct EpiFF2 {
    static constexpr bool PERM = false, AFTER_DRAIN = false;
    float* X1;
    __device__ __forceinline__ void operator()(const f32x4 (&acc)[2][2][4][2], const pg8::Unit& u, int wr, int wc, int fr, int fq) const {
        const int row0 = u.pm * 256 + wr * 64 + fr; const int col0 = u.pn * 256 + wc * 32 + 4 * fq;
#pragma unroll
        EPI_ROWS(ai, m) { const size_t ro = (size_t)(row0 + 128 * ai + 16 * m) * 1024 + col0;
#pragma unroll
            for (int bj = 0; bj < 2; ++bj)
#pragma unroll
                for (int n = 0; n < 2; ++n) { float* p = X1 + ro + 128 * bj + 16 * n; *(f32x4*)p = *(const f32x4*)p + acc[ai][bj][m][n]; } }
    }
};

__device__ __forceinline__ int crow(int r, int hi) { return (r & 3) + 8 * (r >> 2) + 4 * hi; }
template <int DQK, bool MOBA>
__device__ __forceinline__ void attn_unit(int b, int h, int qb, const bf16_t* __restrict__ Qg, const bf16_t* __restrict__ Kg, const bf16_t* __restrict__ Vg, bf16_t* __restrict__ Og,
                                          const float* __restrict__ kmean, LAS unsigned char* lds) {
    constexpr int LDQ = 8 * DQK, ND = DQK / 16, KP = DQK * 2 + 16, VP = 144, KBYTES = 64 * KP, BUF = KBYTES + 64 * VP;
    constexpr int KCH = DQK / 8;
    LAS unsigned* uni = (LAS unsigned*)(lds + 2 * BUF);
    LAS int* tl = (LAS int*)(lds + 2 * BUF + 64);
    int tid_ = threadIdx.x; asm volatile("" : "+v"(tid_));
    const int tid = tid_, lane = tid & 63, wid = __builtin_amdgcn_readfirstlane(tid >> 6), r32 = lane & 31, hi = lane >> 5;
    const size_t rowbase = (size_t)b * SEQ; const int q0 = qb * 256;
    bf16x8 qf[ND];
    { const bf16_t* qrow = Qg + (rowbase + q0 + wid * 32 + r32) * LDQ + h * DQK + 8 * hi;
#pragma unroll
      for (int d0 = 0; d0 < ND; ++d0) qf[d0] = *(const bf16x8*)(qrow + 16 * d0); }
    unsigned selmask = 0u;
    if constexpr (MOBA) {
        float v1 = -INFINITY, v2 = -INFINITY, v3 = -INFINITY; int i1 = -1, i2 = -1, i3 = -1;
        for (int j = 0; j < qb; ++j) {
            const float* km = kmean + (size_t)(b * 32 + j) * 512 + h * 64 + 8 * hi; float s = 0.f;
#pragma unroll
            for (int d0 = 0; d0 < 4; ++d0) { const f32x4 a = *(const f32x4*)(km + 16 * d0), c = *(const f32x4*)(km + 16 * d0 + 4);
                s += bf2f((unsigned short)qf[d0][0]) * a[0] + bf2f((unsigned short)qf[d0][1]) * a[1] + bf2f((unsigned short)qf[d0][2]) * a[2] + bf2f((unsigned short)qf[d0][3]) * a[3]
                   + bf2f((unsigned short)qf[d0][4]) * c[0] + bf2f((unsigned short)qf[d0][5]) * c[1] + bf2f((unsigned short)qf[d0][6]) * c[2] + bf2f((unsigned short)qf[d0][7]) * c[3]; }
            s += __shfl_xor(s, 32);
            if (s > v1) { v3 = v2; i3 = i2; v2 = v1; i2 = i1; v1 = s; i1 = j; }
            else if (s > v2) { v3 = v2; i3 = i2; v2 = s; i2 = j; }
            else if (s > v3) { v3 = s; i3 = j; }
        }
        if (i1 >= 0) selmask |= 1u << i1; if (i2 >= 0) selmask |= 1u << i2; if (i3 >= 0) selmask |= 1u << i3;
        unsigned um = selmask;
#pragma unroll
        for (int o = 1; o < 64; o <<= 1) um |= (unsigned)__shfl_xor((int)um, o);
        if (lane == 0) uni[wid] = um;
        __syncthreads();
    }
    unsigned um;
    if constexpr (MOBA) { um = 0u;
#pragma unroll
        for (int w = 0; w < 8; ++w) um |= uni[w]; um = (unsigned)__builtin_amdgcn_readfirstlane((int)um); }
    else um = (qb == 0) ? 0u : (0xffffffffu >> (32 - qb));
    const int nblk = __builtin_popcount(um); const int nt = 4 * (nblk + 1);
    if (tid < 32) { if ((um >> tid) & 1u) { const int idx = __builtin_popcount(um & ((1u << tid) - 1u));
#pragma unroll
            for (int s = 0; s < 4; ++s) tl[4 * idx + s] = 256 * tid + 64 * s; } }
    else if (tid == 32) {
#pragma unroll
        for (int s = 0; s < 4; ++s) tl[4 * nblk + s] = q0 + 64 * s; }
    __syncthreads();
    const int kr0 = (KCH == 8) ? (tid >> 3) : (tid / 12), kc0 = (KCH == 8) ? (tid & 7) : (tid % 12);
    const int kr1 = (tid + 512) / 12, kc1 = (tid + 512) % 12; const bool has2 = (KCH == 12) && (tid < 256);
    const bf16_t* Kh = Kg + rowbase * LDQ + h * DQK; const bf16_t* Vh = Vg + rowbase * 512 + h * 64;
    const int vkv = tid & 63, vdg = tid >> 6;
    u32x4 kreg0, kreg1 = (u32x4){0u, 0u, 0u, 0u}, vreg;
#define ATT_LOAD(kv0) do { kreg0 = *(const u32x4*)(Kh + (size_t)((kv0) + kr0) * LDQ + 8 * kc0); if (has2) kreg1 = *(const u32x4*)(Kh + (size_t)((kv0) + kr1) * LDQ + 8 * kc1); \
        vreg = *(const u32x4*)(Vh + (size_t)((kv0) + vkv) * 512 + 8 * vdg); } while (0)
#define ATT_STORE(buf) do { LAS unsigned char* kb_ = lds + (buf) * BUF; *(LAS u32x4*)(kb_ + kr0 * KP + 16 * kc0) = kreg0; if (has2) *(LAS u32x4*)(kb_ + kr1 * KP + 16 * kc1) = kreg1; \
        LAS unsigned char* vb_ = kb_ + KBYTES + (8 * vdg) * VP + 2 * vkv; \
        *(LAS unsigned short*)(vb_ + 0 * VP) = (unsigned short)(vreg.x & 0xffffu); *(LAS unsigned short*)(vb_ + 1 * VP) = (unsigned short)(vreg.x >> 16); \
        *(LAS unsigned short*)(vb_ + 2 * VP) = (unsigned short)(vreg.y & 0xffffu); *(LAS unsigned short*)(vb_ + 3 * VP) = (unsigned short)(vreg.y >> 16); \
        *(LAS unsigned short*)(vb_ + 4 * VP) = (unsigned short)(vreg.z & 0xffffu); *(LAS unsigned short*)(vb_ + 5 * VP) = (unsigned short)(vreg.z >> 16); \
        *(LAS unsigned short*)(vb_ + 6 * VP) = (unsigned short)(vreg.w & 0xffffu); *(LAS unsigned short*)(vb_ + 7 * VP) = (unsigned short)(vreg.w >> 16); } while (0)
    ATT_LOAD(tl[0]); ATT_STORE(0);
    __syncthreads();
    f32x16 o0, o1;
#pragma unroll
    for (int r = 0; r < 16; ++r) { o0[r] = 0.f; o1[r] = 0.f; }
    float mrun = -1e30f, lrun = 0.f;
    for (int it = 0; it < nt; ++it) {
        const int kv0 = tl[it]; const int blk = kv0 >> 8; const bool diag = (blk == qb);
        const bool more = (it + 1 < nt);
        if (more) { const int kvn = tl[it + 1]; ATT_LOAD(kvn); }
        const LAS unsigned char* kb = lds + (it & 1) * BUF; const LAS unsigned char* vb = kb + KBYTES;
        const bool active = !(diag && (kv0 - q0) > 32 * wid + 31);
        if (active) {
            f32x16 s0, s1;
#pragma unroll
            for (int r = 0; r < 16; ++r) { s0[r] = 0.f; s1[r] = 0.f; }
#pragma unroll
            for (int d0 = 0; d0 < ND; ++d0) {
                const bf16x8 a0 = *(const LAS bf16x8*)(kb + r32 * KP + (16 * d0 + 8 * hi) * 2);
                const bf16x8 a1 = *(const LAS bf16x8*)(kb + (32 + r32) * KP + (16 * d0 + 8 * hi) * 2);
                s0 = __builtin_amdgcn_mfma_f32_32x32x16_bf16(a0, qf[d0], s0, 0, 0, 0);
                s1 = __builtin_amdgcn_mfma_f32_32x32x16_bf16(a1, qf[d0], s1, 0, 0, 0);
            }
            if (diag) { const int qrel = 32 * wid + r32 - (kv0 - q0);
#pragma unroll
                for (int r = 0; r < 16; ++r) { const int kvr = crow(r, hi); if (kvr > qrel) s0[r] = -INFINITY; if (kvr + 32 > qrel) s1[r] = -INFINITY; } }
            else if (MOBA) { if (!((selmask >> blk) & 1u)) {
#pragma unroll
                    for (int r = 0; r < 16; ++r) { s0[r] = -INFINITY; s1[r] = -INFINITY; } } }
            float mx = fmaxf(s0[0], s1[0]);
#pragma unroll
            for (int r = 1; r < 16; ++r) mx = fmaxf(mx, fmaxf(s0[r], s1[r]));
            mx = fmaxf(mx, __shfl_xor(mx, 32));
            const float mnew = fmaxf(mrun, mx); const float alpha = __builtin_amdgcn_exp2f(mrun - mnew); mrun = mnew;
            float ls = 0.f;
#pragma unroll
            for (int r = 0; r < 16; ++r) { s0[r] = __builtin_amdgcn_exp2f(s0[r] - mnew); s1[r] = __builtin_amdgcn_exp2f(s1[r] - mnew); ls += s0[r] + s1[r]; }
            lrun = lrun * alpha + ls;
#pragma unroll
            for (int r = 0; r < 16; ++r) { o0[r] *= alpha; o1[r] *= alpha; }
#pragma unroll
            for (int kt = 0; kt < 2; ++kt)
#pragma unroll
                for (int uu = 0; uu < 2; ++uu) {
                    u32x4 pw;
                    if (kt == 0) { pw.x = cvtpk(s0[8 * uu + 0], s0[8 * uu + 1]); pw.y = cvtpk(s0[8 * uu + 2], s0[8 * uu + 3]); pw.z = cvtpk(s0[8 * uu + 4], s0[8 * uu + 5]); pw.w = cvtpk(s0[8 * uu + 6], s0[8 * uu + 7]); }
                    else         { pw.x = cvtpk(s1[8 * uu + 0], s1[8 * uu + 1]); pw.y = cvtpk(s1[8 * uu + 2], s1[8 * uu + 3]); pw.z = cvtpk(s1[8 * uu + 4], s1[8 * uu + 5]); pw.w = cvtpk(s1[8 * uu + 6], s1[8 * uu + 7]); }
                    const bf16x8 pb = __builtin_bit_cast(bf16x8, pw);
                    const int kvo = (32 * kt + 16 * uu + 4 * hi) * 2;
#pragma unroll
                    for (int dt = 0; dt < 2; ++dt) {
                        const LAS unsigned char* vp = vb + (32 * dt + r32) * VP + kvo;
                        u32x4 vw; const u32x2 lo = *(const LAS u32x2*)vp, hi2 = *(const LAS u32x2*)(vp + 16); vw.x = lo.x; vw.y = lo.y; vw.z = hi2.x; vw.w = hi2.y;
                        const bf16x8 va = __builtin_bit_cast(bf16x8, vw);
                        if (dt == 0) o0 = __builtin_amdgcn_mfma_f32_32x32x16_bf16(va, pb, o0, 0, 0, 0); else o1 = __builtin_amdgcn_mfma_f32_32x32x16_bf16(va, pb, o1, 0, 0, 0);
                    }
                }
        }
        if (more) ATT_STORE((it + 1) & 1);
        __syncthreads();
    }
#undef ATT_LOAD
#undef ATT_STORE
    lrun += __shfl_xor(lrun, 32);
    const float inv = 1.f / lrun;
    bf16_t* orow = Og + (rowbase + q0 + wid * 32 + r32) * 512 + h * 64 + 4 * hi;
#pragma unroll
    for (int g = 0; g < 4; ++g) {
        st4(orow + 8 * g, (f32x4){o0[4 * g] * inv, o0[4 * g + 1] * inv, o0[4 * g + 2] * inv, o0[4 * g + 3] * inv});
        st4(orow + 32 + 8 * g, (f32x4){o1[4 * g] * inv, o1[4 * g + 1] * inv, o1[4 * g + 2] * inv, o1[4 * g + 3] * inv});
    }
}

__device__ __forceinline__ int win_src_col(int p) {
    if (p < 1024) { const int base = p & ~63, w = p & 63, g = w >> 5, ww = w & 31; return base + (ww < 16 ? 16 * g + ww : 32 + 16 * g + (ww - 16)); }
    if (p < 2208) return p;
    if (p < 2304) return -1;
    return p - 96;
}
__device__ __forceinline__ void transpose_item(const float* __restrict__ W, int K, int Nsrc, int nblk, bf16_t* WT, const float* gk, bool winmap, LAS float* scr, int item, int lane) {
    const int kb = item / nblk, nb = item % nblk, k0 = 64 * kb, n0 = 32 * nb;
    const int np = n0 + (lane & 31); const int sc = winmap ? win_src_col(np) : np;
#pragma unroll 8
    for (int i = 0; i < 32; ++i) { const int kk = 2 * i + (lane >> 5); float v = (sc >= 0) ? W[(size_t)(k0 + kk) * Nsrc + sc] : 0.f; if (gk) v *= gk[k0 + kk]; scr[kk * 33 + (lane & 31)] = v; }
    asm volatile("s_waitcnt lgkmcnt(0)" ::: "memory");
    const int c = lane & 7;
#pragma unroll
    for (int j = 0; j < 4; ++j) { const int n = (lane >> 3) + 8 * j; const LAS float* s = scr + (8 * c) * 33 + n;
        u32x4 o; o.x = cvtpk(s[0 * 33], s[1 * 33]); o.y = cvtpk(s[2 * 33], s[3 * 33]); o.z = cvtpk(s[4 * 33], s[5 * 33]); o.w = cvtpk(s[6 * 33], s[7 * 33]);
        *(u32x4*)(WT + (size_t)(n0 + n) * K + k0 + 8 * c) = o; }
    asm volatile("s_waitcnt lgkmcnt(0)" ::: "memory");
}

#define GRID_SYNC() xcd_barrier(xbar)
struct Args { const float* in[15]; float* out; unsigned char* ws; };

__global__ void __launch_bounds__(NTHREADS, 2) fwd_megakernel(Args a) {
    extern __shared__ __attribute__((aligned(16))) unsigned char lds_raw[];
    LAS unsigned char* lds = (LAS unsigned char*)lds_raw;
    cg::grid_group grid = cg::this_grid();
    if (a.ws == nullptr) grid.sync();
    volatile LAS unsigned* MISC = (volatile LAS unsigned*)(lds + 131072 + 320);
    if (threadIdx.x < 32) MISC[threadIdx.x] = 0u;
    __syncthreads();
    XcdBarrier xbar = xcd_barrier_post((unsigned*)(a.ws + WS_BAR), MISC + 8);
    const int G = gridDim.x, bx = blockIdx.x; const int vcu = (G % 8 == 0) ? (bx % 8) * (G / 8) + bx / 8 : bx;
    unsigned char* ws = a.ws;
    const float *x = a.in[0], *g_mix = a.in[1], *w_in = a.in[2], *b_gate = a.in[3], *g_cq = a.in[4], *w_q_up = a.in[5], *g_ckv = a.in[6], *w_kv_up = a.in[7],
                *w_o_a = a.in[8], *w_o_b = a.in[9], *w_out = a.in[10], *g_mlp = a.in[11], *w_ff1 = a.in[12], *w_ff2 = a.in[13], *g_final = a.in[14];
    float* out = a.out;
    float *ROWSS_Q = (float*)(ws + WS_ROWSS_Q), *ROWSS_KV = (float*)(ws + WS_ROWSS_KV), *ROWSS2 = (float*)(ws + WS_ROWSS2), *KMEAN = (float*)(ws + WS_KMEAN);
    bf16_t *WIN = (bf16_t*)(ws + WS_WIN), *WQUP = (bf16_t*)(ws + WS_WQUP), *WKVUP = (bf16_t*)(ws + WS_WKVUP), *WOA = (bf16_t*)(ws + WS_WOA), *WOB = (bf16_t*)(ws + WS_WOB),
           *WOUT = (bf16_t*)(ws + WS_WOUT), *WFF1 = (bf16_t*)(ws + WS_WFF1), *WFF2 = (bf16_t*)(ws + WS_WFF2);
    float *ROPE64 = (float*)(ws + WS_ROPE64), *ROPE32 = (float*)(ws + WS_ROPE32);
    bf16_t *XN = (bf16_t*)(ws + WS_XN), *OA = (bf16_t*)(ws + WS_OA), *OB = (bf16_t*)(ws + WS_OB), *X1B = (bf16_t*)(ws + WS_X1B);
    bf16_t *QA = (bf16_t*)(ws + WS_QA), *KA = (bf16_t*)(ws + WS_KA), *VA = (bf16_t*)(ws + WS_VA), *CQ = (bf16_t*)(ws + WS_CQ), *CKV = (bf16_t*)(ws + WS_CKV),
           *QB = (bf16_t*)(ws + WS_QB), *KB = (bf16_t*)(ws + WS_KB), *VB = (bf16_t*)(ws + WS_VB), *Z = (bf16_t*)(ws + WS_Z), *U = (bf16_t*)(ws + WS_U);
    bf16_t* GT = (bf16_t*)out;

    {
        int tid_ = threadIdx.x; asm volatile("" : "+v"(tid_)); const int tid = tid_, lane = tid & 63, wave = __builtin_amdgcn_readfirstlane(tid >> 6);
        const int gw = vcu * 8 + wave, NGW = G * 8;
        const int gt = bx * NTHREADS + tid, NGT = G * NTHREADS;
        for (int i = gt; i < (int)(WS_CTL_END / 4); i += NGT) ((float*)ws)[i] = 0.f;
        for (int i = gt; i < SEQ * 32; i += NGT) { const int pos = i >> 5, f = i & 31; const float inv = __builtin_amdgcn_exp2f(-(float)f * (13.287712379549449f / 32.f)); const float ang = (float)pos * inv;
            double rev = (double)ang * 0.15915494309189535; rev -= __builtin_rint(rev); const float fr = (float)rev;
            ROPE64[2 * i] = __builtin_amdgcn_cosf(fr); ROPE64[2 * i + 1] = __builtin_amdgcn_sinf(fr); }
        for (int i = gt; i < SEQ * 16; i += NGT) { const int pos = i >> 4, f = i & 15; const float inv = __builtin_amdgcn_exp2f(-(float)f * (13.287712379549449f / 16.f)); const float ang = (float)pos * inv;
            double rev = (double)ang * 0.15915494309189535; rev -= __builtin_rint(rev); const float fr = (float)rev;
            ROPE32[2 * i] = __builtin_amdgcn_cosf(fr); ROPE32[2 * i + 1] = __builtin_amdgcn_sinf(fr); }
        LAS float* scr = (LAS float*)(lds + wave * 16384);
        constexpr int I_IN = 16 * 136, I_QUP = 6 * 24, I_KVUP = 4 * 32, I_OA = 8 * 32, I_OUT = 16 * 32, I_FF1 = 16 * 128, I_FF2 = 64 * 32;
        constexpr int NITEMS = I_IN + I_QUP + I_KVUP + 2 * I_OA + I_OUT + I_FF1 + I_FF2;
        for (int it = gw; it < NITEMS; it += NGW) {
            int r = it;
            if (r < I_IN) { transpose_item(w_in, 1024, 4256, 136, WIN, nullptr, true, scr, r, lane); continue; } r -= I_IN;
            if (r < I_QUP) { transpose_item(w_q_up, 384, 768, 24, WQUP, g_cq, false, scr, r, lane); continue; } r -= I_QUP;
            if (r < I_KVUP) { transpose_item(w_kv_up, 256, 1024, 32, WKVUP, g_ckv, false, scr, r, lane); continue; } r -= I_KVUP;
            if (r < I_OA) { transpose_item(w_o_a, 512, 1024, 32, WOA, nullptr, false, scr, r, lane); continue; } r -= I_OA;
            if (r < I_OA) { transpose_item(w_o_b, 512, 1024, 32, WOB, nullptr, false, scr, r, lane); continue; } r -= I_OA;
            if (r < I_OUT) { transpose_item(w_out, 1024, 1024, 32, WOUT, nullptr, false, scr, r, lane); continue; } r -= I_OUT;
            if (r < I_FF1) { transpose_item(w_ff1, 1024, 4096, 128, WFF1, g_mlp, false, scr, r, lane); continue; } r -= I_FF1;
            transpose_item(w_ff2, 4096, 1024, 32, WFF2, nullptr, false, scr, r, lane);
        }
        f32x4 gm[4];
#pragma unroll
        for (int j = 0; j < 4; ++j) gm[j] = *((const f32x4*)g_mix + lane + 64 * j);
        for (int m = gw; m < M; m += NGW) {
            const f32x4* xr = (const f32x4*)(x + (size_t)m * DM) + lane; f32x4 v[4]; float s = 0.f;
#pragma unroll
            for (int j = 0; j < 4; ++j) { v[j] = xr[64 * j]; s += (v[j][0] * v[j][0] + v[j][1] * v[j][1]) + (v[j][2] * v[j][2] + v[j][3] * v[j][3]); }
            const float rs = rsqrtf(wave_sum(s) * (1.f / DM) + EPS);
#pragma unroll
            for (int j = 0; j < 4; ++j) st4(XN + (size_t)m * DM + 4 * (lane + 64 * j), v[j] * rs * gm[j]);
        }
    }
    GRID_SYNC();
#if defined(DBG_STOP)
    if (DBG_STOP == 0) { int tid_ = threadIdx.x; asm volatile("" : "+v"(tid_)); const size_t gt = (size_t)bx * NTHREADS + tid_, NGT = (size_t)G * NTHREADS;
        const bf16_t* s0_ = (DBG_STOP == 0) ? XN : (DBG_STOP == 1) ? QA : (DBG_STOP == 2) ? QB : (DBG_STOP == 3) ? OA : Z;
        const bf16_t* s1_ = (DBG_STOP == 0) ? XN : (DBG_STOP == 1) ? CQ : (DBG_STOP == 2) ? VB : (DBG_STOP == 3) ? OB : Z;
        GRID_SYNC();
        for (size_t i = gt; i < (size_t)M * 512; i += NGT) { out[i] = bf2f(s0_[i]); out[(size_t)M * 512 + i] = bf2f(s1_[i]); }
        return; }
#endif
    { pg8::Gemm g{XN, WIN, M, NIN, 1024}; pg8::StaticOrder S; S.init(M, NIN, G, bx);
      EpiProj E{QA, KA, VA, CQ, CKV, KB, GT, ROWSS_Q, ROWSS_KV, KMEAN, ROPE64, ROPE32, b_gate};
      pg8::gemm_phase<EpiProj, pg8::StaticOrder, true, true>(lds, g, S, E); }
    GRID_SYNC();
#if defined(DBG_STOP)
    if (DBG_STOP == 1) { int tid_ = threadIdx.x; asm volatile("" : "+v"(tid_)); const size_t gt = (size_t)bx * NTHREADS + tid_, NGT = (size_t)G * NTHREADS;
        const bf16_t* s0_ = (DBG_STOP == 0) ? XN : (DBG_STOP == 1) ? QA : (DBG_STOP == 2) ? QB : (DBG_STOP == 3) ? OA : Z;
        const bf16_t* s1_ = (DBG_STOP == 0) ? XN : (DBG_STOP == 1) ? CQ : (DBG_STOP == 2) ? VB : (DBG_STOP == 3) ? OB : Z;
        GRID_SYNC();
        for (size_t i = gt; i < (size_t)M * 512; i += NGT) { out[i] = bf2f(s0_[i]); out[(size_t)M * 512 + i] = bf2f(s1_[i]); }
        return; }
#endif
    { pg8::Gemm g{CQ, WQUP, M, 768, 384}; pg8::StaticOrder S; S.init(M, 768, G, bx); EpiQup E{QB, ROWSS_Q, ROPE32};
      pg8::gemm_phase<EpiQup, pg8::StaticOrder, true, true>(lds, g, S, E); }
    __syncthreads();
    { pg8::Gemm g{CKV, WKVUP, M, 1024, 256}; pg8::StaticOrder S; S.init(M, 1024, G, bx); EpiKVup E{KB, VB, ROWSS_KV};
      pg8::gemm_phase<EpiKVup, pg8::StaticOrder, true, true>(lds, g, S, E); }
    GRID_SYNC();
#if defined(DBG_STOP)
    if (DBG_STOP == 2) { int tid_ = threadIdx.x; asm volatile("" : "+v"(tid_)); const size_t gt = (size_t)bx * NTHREADS + tid_, NGT = (size_t)G * NTHREADS;
        const bf16_t* s0_ = (DBG_STOP == 0) ? XN : (DBG_STOP == 1) ? QA : (DBG_STOP == 2) ? QB : (DBG_STOP == 3) ? OA : Z;
        const bf16_t* s1_ = (DBG_STOP == 0) ? XN : (DBG_STOP == 1) ? CQ : (DBG_STOP == 2) ? VB : (DBG_STOP == 3) ? OB : Z;
        GRID_SYNC();
        for (size_t i = gt; i < (size_t)M * 512; i += NGT) { out[i] = bf2f(s0_[i]); out[(size_t)M * 512 + i] = bf2f(s1_[i]); }
        return; }
#endif
#if defined(PROBE_REP)
    for (int rep_ = 0; rep_ < 2; ++rep_)
#endif
    for (int p = vcu; p < 512; p += G) {
#if defined(PROBE_REP)
        if (rep_ == 1 && (p >> 8) != PROBE_REP) continue;
#endif
        const int kind = p >> 8, bh = (p & 255) >> 4, s = p & 15, b = bh >> 3, h = bh & 7;
        if (kind == 0) { attn_unit<96, false>(b, h, 31 - s, QB, KB, VB, OB, nullptr, lds); attn_unit<96, false>(b, h, s, QB, KB, VB, OB, nullptr, lds); }
        else           { attn_unit<64, true>(b, h, 31 - s, QA, KA, VA, OA, KMEAN, lds); attn_unit<64, true>(b, h, s, QA, KA, VA, OA, KMEAN, lds); }
    }
    GRID_SYNC();
#if defined(DBG_STOP)
    if (DBG_STOP == 3) { int tid_ = threadIdx.x; asm volatile("" : "+v"(tid_)); const size_t gt = (size_t)bx * NTHREADS + tid_, NGT = (size_t)G * NTHREADS;
        const bf16_t* s0_ = (DBG_STOP == 0) ? XN : (DBG_STOP == 1) ? QA : (DBG_STOP == 2) ? QB : (DBG_STOP == 3) ? OA : Z;
        const bf16_t* s1_ = (DBG_STOP == 0) ? XN : (DBG_STOP == 1) ? CQ : (DBG_STOP == 2) ? VB : (DBG_STOP == 3) ? OB : Z;
        GRID_SYNC();
        for (size_t i = gt; i < (size_t)M * 512; i += NGT) { out[i] = bf2f(s0_[i]); out[(size_t)M * 512 + i] = bf2f(s1_[i]); }
        return; }
#endif
    { pg8::Gemm g{OA, WOA, M, 1024, 512}; pg8::StaticOrder S; S.init(M, 1024, G, bx); EpiGate<false> E{Z, GT};
      pg8::gemm_phase<EpiGate<false>, pg8::StaticOrder, true, true>(lds, g, S, E); }
    __syncthreads();
    { pg8::Gemm g{OB, WOB, M, 1024, 512}; pg8::StaticOrder S; S.init(M, 1024, G, bx); EpiGate<true> E{Z, GT + (size_t)M * 1024};
      pg8::gemm_phase<EpiGate<true>, pg8::StaticOrder, true, true>(lds, g, S, E); }
    GRID_SYNC();
#if defined(DBG_STOP)
    if (DBG_STOP == 4) { int tid_ = threadIdx.x; asm volatile("" : "+v"(tid_)); const size_t gt = (size_t)bx * NTHREADS + tid_, NGT = (size_t)G * NTHREADS;
        const bf16_t* s0_ = (DBG_STOP == 0) ? XN : (DBG_STOP == 1) ? QA : (DBG_STOP == 2) ? QB : (DBG_STOP == 3) ? OA : Z;
        const bf16_t* s1_ = (DBG_STOP == 0) ? XN : (DBG_STOP == 1) ? CQ : (DBG_STOP == 2) ? VB : (DBG_STOP == 3) ? OB : Z;
        GRID_SYNC();
        for (size_t i = gt; i < (size_t)M * 512; i += NGT) { out[i] = bf2f(s0_[i]); out[(size_t)M * 512 + i] = bf2f(s1_[i]); }
        return; }
#endif
    { pg8::Gemm g{Z, WOUT, M, 1024, 1024}; pg8::StaticOrder S; S.init(M, 1024, G, bx); EpiOut E{x, out, X1B, ROWSS2};
      pg8::gemm_phase<EpiOut, pg8::StaticOrder, true, true>(lds, g, S, E); }
    GRID_SYNC();
    { pg8::Gemm g{X1B, WFF1, M, FF, 1024}; pg8::StaticOrder S; S.init(M, FF, G, bx); EpiFF1 E{U, ROWSS2};
      pg8::gemm_phase<EpiFF1, pg8::StaticOrder, true, true>(lds, g, S, E); }
    GRID_SYNC();
    { pg8::Gemm g{U, WFF2, M, 1024, FF}; pg8::StaticOrder S; S.init(M, 1024, G, bx); EpiFF2 E{out};
      pg8::gemm_phase<EpiFF2, pg8::StaticOrder, true, true>(lds, g, S, E); }
    GRID_SYNC();
    {
        int tid_ = threadIdx.x; asm volatile("" : "+v"(tid_)); const int tid = tid_, lane = tid & 63, wave = __builtin_amdgcn_readfirstlane(tid >> 6);
        const int gw = vcu * 8 + wave, NGW = G * 8;
        f32x4 gf[4];
#pragma unroll
        for (int j = 0; j < 4; ++j) gf[j] = *((const f32x4*)g_final + lane + 64 * j);
        for (int m = gw; m < M; m += NGW) {
            f32x4* xr = (f32x4*)(out + (size_t)m * DM) + lane; f32x4 v[4]; float s = 0.f;
#pragma unroll
            for (int j = 0; j < 4; ++j) { v[j] = xr[64 * j]; s += (v[j][0] * v[j][0] + v[j][1] * v[j][1]) + (v[j][2] * v[j][2] + v[j][3] * v[j][3]); }
            const float rs = rsqrtf(wave_sum(s) * (1.f / DM) + EPS);
#pragma unroll
            for (int j = 0; j < 4; ++j) xr[64 * j] = v[j] * rs * gf[j];
        }
    }
}

extern "C" void kernel_launch(void* const* d_in, const int* in_sizes, int n_in, void* d_out, int out_size, void* d_ws, size_t ws_size, hipStream_t stream) {
    static int grid = 0;
    if (grid == 0) {
        if (n_in != 15 || out_size != M * DM || ws_size < WS_END) { fprintf(stderr, "kernel_launch: unexpected shapes (n_in %d out %d ws %zu)\n", n_in, out_size, ws_size); grid = -1; return; }
        int dev = 0, cus = 0, per_cu = 0;
        hipGetDevice(&dev); hipDeviceGetAttribute(&cus, hipDeviceAttributeMultiprocessorCount, dev);
        if (hipFuncSetAttribute((const void*)fwd_megakernel, hipFuncAttributeMaxDynamicSharedMemorySize, LDS_BYTES) != hipSuccess) { fprintf(stderr, "kernel_launch: hipFuncSetAttribute failed\n"); grid = -1; return; }
        if (hipOccupancyMaxActiveBlocksPerMultiprocessor(&per_cu, (const void*)fwd_megakernel, NTHREADS, LDS_BYTES) != hipSuccess || per_cu < 1) { fprintf(stderr, "kernel_launch: occupancy query gave %d\n", per_cu); per_cu = 1; }
        (void)hipGetLastError();
        grid = cus * per_cu;
    }
    if (grid < 0) return;
    if (hipMemsetAsync((char*)d_ws + WS_BAR, 0, WS_BAR_BYTES, stream) != hipSuccess) { fprintf(stderr, "kernel_launch: memset failed\n"); return; }
    Args a{};
    for (int i = 0; i < 15; ++i) a.in[i] = (const float*)d_in[i];
    a.out = (float*)d_out; a.ws = (unsigned char*)d_ws;
    void* args[] = {&a};
    hipError_t e = hipLaunchCooperativeKernel((const void*)fwd_megakernel, dim3(grid), dim3(NTHREADS), args, LDS_BYTES, stream);
    if (e != hipSuccess) fprintf(stderr, "cooperative launch failed: %s (grid %d)\n", hipGetErrorString(e), grid);
}
```

```cpp
#include <hip/hip_runtime.h>
#include <hip/hip_cooperative_groups.h>
#include <cstdio>
#include <cstdint>
namespace cg = cooperative_groups;
namespace pg8 {
#define PG8_LAS __attribute__((address_space(3)))
typedef unsigned short bf16_t;
typedef short bf16x8 __attribute__((ext_vector_type(8)));
typedef float f32x4 __attribute__((ext_vector_type(4)));
typedef unsigned u32x4 __attribute__((ext_vector_type(4)));
constexpr int BM = 256, BK = 64, HALF = 128, HTB = HALF * BK * 2  , STAGE_BYTES = 8 * HTB, NXCD = 8, WGM = 8;

__host__ __device__ __forceinline__ int lds_byte(int r, int c) { const int st = (r >> 4) * 2 + (c >> 5), rr = r & 15, cc = c & 31, ob = rr * 64 + cc * 2; return st * 1024 + (ob ^ (((ob >> 9) & 1) << 5)); }
__host__ __device__ __forceinline__ void stage_rc(int b, int& R, int& C) { const int st = b / 1024, sb = b % 1024, swz = sb ^ (((sb >> 9) & 1) << 5); R = (st >> 1) * 16 + swz / 64; C = (st & 1) * 32 + (swz % 64) / 2; }
__host__ __device__ __forceinline__ int perm32(int rho) { const int n = rho >> 4, i = rho & 15; return 8 * (i >> 2) + 4 * n + (i & 3); }

struct Unit { int pm, pn; };
struct Gemm { const bf16_t* A; const bf16_t* Bt; int M, N, K; };

struct StaticOrder {
    int nM, nN, nwg, G, c;
    __host__ __device__ void init(int M, int N, int G_, int c_) { nM = M / BM; nN = N / BM; nwg = nM * nN; G = G_; c = c_; }
    __host__ __device__ bool next(int i, Unit& u) const {
        const long L = (long)i * G + c; if (L >= nwg) return false;
        int wgid = (int)L; { const int q = nwg / NXCD, r = nwg % NXCD, xcd = wgid % NXCD, off = wgid / NXCD; wgid = (xcd < r ? xcd * (q + 1) : r * (q + 1) + (xcd - r) * q) + off; }
        const int nig = WGM * nN, gid = wgid / nig, fm = gid * WGM, gsz = (nM - fm) < WGM ? (nM - fm) : WGM;
        u.pm = fm + ((wgid % nig) % gsz); u.pn = (wgid % nig) / gsz; return true;
    }
    __device__ __forceinline__ void a_ready(const Unit&) const {}
    __device__ __forceinline__ void done(const Unit&) const {}
};

__device__ __forceinline__ unsigned cvt_pk_bf16(float lo, float hi) { unsigned r; asm volatile("v_cvt_pk_bf16_f32 %0, %1, %2" : "=v"(r) : "v"(lo), "v"(hi)); return r; }
typedef float f32x2 __attribute__((ext_vector_type(2)));
template <class Epi, class Sched, bool ALIGN_EPI = false, bool SP2 = false>
__device__ __forceinline__ void gemm_phase(PG8_LAS unsigned char* lds, const Gemm g, const Sched& S, const Epi& E) {
    int tid_ = threadIdx.x; asm volatile("" : "+v"(tid_));
    const int tid = tid_, wid = __builtin_amdgcn_readfirstlane(tid >> 6), lane = tid & 63, wr = wid >> 2, wc = wid & 3, fr = lane & 15, fq = lane >> 4;
    const int K = g.K, nt = K / BK;
    unsigned voffA[2], voffB[2];
#pragma unroll
    for (int i = 0; i < 2; ++i) { int R, C; stage_rc(tid * 16 + i * 8192, R, C); const int Rb = Epi::PERM ? ((R & ~31) + perm32(R & 31)) : R;
        voffA[i] = (unsigned)(R * K + C) * 2u; voffB[i] = (unsigned)(Rb * K + C) * 2u; }
    const size_t kstep = (size_t)(BK * 2);
    const size_t hstep = (size_t)HALF * K * 2;
    const size_t tstep = 2 * hstep;
    const unsigned ldsw = (unsigned)wid * 1024u;
    const int aoff = lds_byte(wr * 64 + fr, fq * 8), boff = lds_byte(wc * 32 + fr, fq * 8);
#define PG8_SA(b, h) (((b) * 2 + (h)) * HTB)
#define PG8_SB(b, h) ((4 + (b) * 2 + (h)) * HTB)
#define PG8_STAGE(bufoff, gbase, voff) do { _Pragma("unroll") for (int _i = 0; _i < 2; ++_i) \
        __builtin_amdgcn_global_load_lds((const unsigned*)((const char*)(gbase) + (voff)[_i]), (PG8_LAS unsigned*)(lds + (bufoff) + ldsw + _i * 8192), 16, 0, 0); } while (0)
#define PG8_LDA(dst, b, h) do { _Pragma("unroll") for (int m = 0; m < 4; ++m) _Pragma("unroll") for (int k = 0; k < 2; ++k) dst[m][k] = *(const PG8_LAS bf16x8*)(lds + PG8_SA(b, h) + aoff + m * 2048 + k * 1024); } while (0)
#define PG8_LDB(dst, b, h) do { _Pragma("unroll") for (int n = 0; n < 2; ++n) _Pragma("unroll") for (int k = 0; k < 2; ++k) dst[n][k] = *(const PG8_LAS bf16x8*)(lds + PG8_SB(b, h) + boff + n * 2048 + k * 1024); } while (0)
#define PG8_MMA(ai, bj, At, Bt) do { __builtin_amdgcn_s_setprio(1); _Pragma("unroll") for (int m = 0; m < 4; ++m) _Pragma("unroll") for (int n = 0; n < 2; ++n) _Pragma("unroll") for (int k = 0; k < 2; ++k) \
        acc[ai][bj][m][n] = __builtin_amdgcn_mfma_f32_16x16x32_bf16(Bt[n][k], At[m][k], acc[ai][bj][m][n], 0, 0, 0); __builtin_amdgcn_s_setprio(0); } while (0)
#define PG8_WAIT_V(n) asm volatile("s_waitcnt vmcnt(" #n ")" ::: "memory")
#define PG8_WAIT_L(n) asm volatile("s_waitcnt lgkmcnt(" #n ")" ::: "memory")
#define PG8_BAR __builtin_amdgcn_s_barrier()
#define PG8_SCHED __builtin_amdgcn_sched_barrier(0)
    Unit cur, nxt; int ui = 0;
    if (!S.next(0, cur)) return;
    f32x4 acc[2][2][4][2];
#pragma unroll
    for (int a = 0; a < 2; ++a)
#pragma unroll
        for (int b = 0; b < 2; ++b)
#pragma unroll
            for (int m = 0; m < 4; ++m)
#pragma unroll
                for (int n = 0; n < 2; ++n) acc[a][b][m][n] = (f32x4){0.f, 0.f, 0.f, 0.f};
    bf16x8 At[4][2], B0[2][2], B1[2][2];
    const char* cA = (const char*)g.A + (size_t)cur.pm * tstep; const char* cB = (const char*)g.Bt + (size_t)cur.pn * tstep;
    S.a_ready(cur);
    if constexpr (SP2) {
        PG8_STAGE(PG8_SB(0, 0), cB, voffB); PG8_STAGE(PG8_SB(0, 1), cB + hstep, voffB); PG8_STAGE(PG8_SA(0, 0), cA, voffA); PG8_STAGE(PG8_SA(0, 1), cA + hstep, voffA);
        if (wr == 1) PG8_BAR;
        PG8_WAIT_V(2); PG8_BAR;
        PG8_STAGE(PG8_SB(1, 0), cB + kstep, voffB); PG8_STAGE(PG8_SA(1, 0), cA + kstep, voffA); PG8_STAGE(PG8_SB(1, 1), cB + hstep + kstep, voffB);
        PG8_WAIT_V(6); PG8_BAR;
    } else {
        PG8_STAGE(PG8_SB(0, 0), cB, voffB); PG8_STAGE(PG8_SA(0, 0), cA, voffA); PG8_STAGE(PG8_SB(0, 1), cB + hstep, voffB); PG8_STAGE(PG8_SA(0, 1), cA + hstep, voffA);
        if (wr == 1) PG8_BAR;
        PG8_WAIT_V(4); PG8_BAR;
        PG8_STAGE(PG8_SB(1, 0), cB + kstep, voffB); PG8_STAGE(PG8_SA(1, 0), cA + kstep, voffA); PG8_STAGE(PG8_SB(1, 1), cB + hstep + kstep, voffB);
        PG8_WAIT_V(6); PG8_BAR;
    }
    for (;;) {
        const bool has_next = S.next(ui + 1, nxt);
        const char* nA = has_next ? (const char*)g.A + (size_t)nxt.pm * tstep : cA; const char* nB = has_next ? (const char*)g.Bt + (size_t)nxt.pn * tstep : cB;
        for (int t = 0; t < nt; t += 2) {
            const bool last = (t == nt - 2);
            const char* a1 = cA + (size_t)(t + 1) * kstep;
            const char* a2 = last ? nA : cA + (size_t)(t + 2) * kstep; const char* b2 = last ? nB : cB + (size_t)(t + 2) * kstep;
            const char* a3 = a2 + kstep; const char* b3 = b2 + kstep;
            if (last && has_next) S.a_ready(nxt);
            if constexpr (SP2) {
            PG8_LDB(B0, 0, 0); PG8_LDB(B1, 0, 1); PG8_SCHED; PG8_LDA(At, 0, 0); PG8_STAGE(PG8_SA(1, 1), a1 + hstep, voffA);
            PG8_WAIT_V(8); PG8_WAIT_L(0); PG8_BAR; PG8_MMA(0, 0, At, B0); PG8_MMA(0, 1, At, B1); PG8_BAR; PG8_SCHED;
            PG8_LDA(At, 0, 1); PG8_STAGE(PG8_SB(0, 0), b2, voffB); PG8_STAGE(PG8_SB(0, 1), b2 + hstep, voffB); PG8_STAGE(PG8_SA(0, 0), a2, voffA);
            PG8_WAIT_V(8); PG8_WAIT_L(0); PG8_BAR; PG8_MMA(1, 0, At, B0); PG8_MMA(1, 1, At, B1); PG8_BAR; PG8_SCHED;
            PG8_LDB(B0, 1, 0); PG8_LDB(B1, 1, 1); PG8_SCHED; PG8_LDA(At, 1, 0); PG8_STAGE(PG8_SA(0, 1), a2 + hstep, voffA);
            PG8_WAIT_V(8); PG8_WAIT_L(0); PG8_BAR; PG8_MMA(0, 0, At, B0); PG8_MMA(0, 1, At, B1); PG8_BAR; PG8_SCHED;
            PG8_LDA(At, 1, 1); PG8_STAGE(PG8_SB(1, 0), b3, voffB); PG8_STAGE(PG8_SB(1, 1), b3 + hstep, voffB); PG8_STAGE(PG8_SA(1, 0), a3, voffA);
            PG8_WAIT_V(8); PG8_WAIT_L(0); PG8_BAR; PG8_MMA(1, 0, At, B0); PG8_MMA(1, 1, At, B1); PG8_BAR; PG8_SCHED;
            } else {
            PG8_LDB(B0, 0, 0); PG8_SCHED; PG8_LDA(At, 0, 0); PG8_STAGE(PG8_SA(1, 1), a1 + hstep, voffA);
            PG8_WAIT_L(8); PG8_BAR; PG8_WAIT_L(0); PG8_MMA(0, 0, At, B0); PG8_BAR; PG8_SCHED;
            PG8_LDB(B1, 0, 1); PG8_STAGE(PG8_SB(0, 0), b2, voffB);
            PG8_BAR; PG8_WAIT_L(0); PG8_MMA(0, 1, At, B1); PG8_BAR;
            PG8_LDA(At, 0, 1); PG8_STAGE(PG8_SA(0, 0), a2, voffA);
            PG8_BAR; PG8_WAIT_L(0); PG8_MMA(1, 0, At, B0); PG8_BAR; PG8_SCHED;
            PG8_STAGE(PG8_SB(0, 1), b2 + hstep, voffB);
            PG8_WAIT_V(6); PG8_BAR; PG8_MMA(1, 1, At, B1); PG8_BAR;
            PG8_LDB(B0, 1, 0); PG8_SCHED; PG8_LDA(At, 1, 0); PG8_STAGE(PG8_SA(0, 1), a2 + hstep, voffA);
            PG8_WAIT_L(8); PG8_BAR; PG8_WAIT_L(0); PG8_MMA(0, 0, At, B0); PG8_BAR; PG8_SCHED;
            PG8_LDB(B1, 1, 1); PG8_STAGE(PG8_SB(1, 0), b3, voffB);
            PG8_BAR; PG8_WAIT_L(0); PG8_MMA(0, 1, At, B1); PG8_BAR;
            PG8_LDA(At, 1, 1); PG8_STAGE(PG8_SA(1, 0), a3, voffA);
            PG8_BAR; PG8_WAIT_L(0); PG8_MMA(1, 0, At, B0); PG8_BAR; PG8_SCHED;
            PG8_STAGE(PG8_SB(1, 1), b3 + hstep, voffB);
            PG8_WAIT_V(6); PG8_BAR; PG8_MMA(1, 1, At, B1); PG8_BAR;
            }
        }
        if constexpr (ALIGN_EPI) { if (wr == 0) PG8_BAR; }
        if constexpr (!Epi::AFTER_DRAIN) { E(acc, cur, wr, wc, fr, fq); S.done(cur); }
        if (!has_next) break;
#pragma unroll
        for (int a = 0; a < 2; ++a)
#pragma unroll
            for (int b = 0; b < 2; ++b)
#pragma unroll
                for (int m = 0; m < 4; ++m)
#pragma unroll
                    for (int n = 0; n < 2; ++n) acc[a][b][m][n] = (f32x4){0.f, 0.f, 0.f, 0.f};
        cur = nxt; cA = nA; cB = nB; ++ui;
        if constexpr (ALIGN_EPI) { if (wr == 1) PG8_BAR; }
    }
    PG8_WAIT_V(0);
    if constexpr (!ALIGN_EPI) { if (wr == 0) PG8_BAR; }
    PG8_BAR;
    if constexpr (Epi::AFTER_DRAIN) { E.fused(acc, cur, wr, wc, fr, fq, lds, wid, lane); S.done(cur); }
#undef PG8_SA
#undef PG8_SB
#undef PG8_STAGE
#undef PG8_LDA
#undef PG8_LDB
#undef PG8_MMA
#undef PG8_WAIT_V
#undef PG8_WAIT_L
#undef PG8_BAR
#undef PG8_SCHED
}
}

#define LAS __attribute__((address_space(3)))
typedef unsigned short bf16_t;
typedef short bf16x8 __attribute__((ext_vector_type(8)));
typedef float f32x4 __attribute__((ext_vector_type(4)));
typedef float f32x16 __attribute__((ext_vector_type(16)));
typedef unsigned u32x2 __attribute__((ext_vector_type(2)));
typedef unsigned u32x4 __attribute__((ext_vector_type(4)));

#define XB_TMO      128
#define XB_XCNT(j)  (256  + 64 * (j))
#define XB_XSUB(j)  (1280 + 64 * (j))
#define XB_XGEN(j)  (2304 + 64 * (j))
#define XB_TOP      3328
#define XB_TOPGEN   3392
#define XCD_BAR_WORDS 3456
#define XB_SPIN_CAP (1u << 18)

__device__ __forceinline__ unsigned xb_ld(unsigned* p)              { return __hip_atomic_load(p, __ATOMIC_RELAXED, __HIP_MEMORY_SCOPE_AGENT); }
__device__ __forceinline__ unsigned xb_add(unsigned* p, unsigned v) { return __hip_atomic_fetch_add(p, v, __ATOMIC_RELAXED, __HIP_MEMORY_SCOPE_AGENT); }
__device__ __forceinline__ unsigned xb_xcc_id() { return (unsigned)__builtin_amdgcn_s_getreg((3 << 11) | 20) & 0xFu; }
#define XB_SPIN(cond, bar) do { unsigned _sp = 0; while (cond) { __builtin_amdgcn_s_sleep(1); \
    if ((++_sp & 255u) == 0u) { if (xb_ld(&(bar)[XB_TMO])) break; if (_sp > XB_SPIN_CAP) { atomicAdd(&(bar)[XB_TMO], 1u); break; } } } } while (0)

struct XcdBarrier {
    unsigned* bar; unsigned x;
    volatile LAS unsigned* st;
};

__device__ __forceinline__ XcdBarrier xcd_barrier_post(unsigned* bar, volatile LAS unsigned* st) {
    XcdBarrier b; b.bar = bar; b.x = xb_xcc_id(); b.st = st;
    if (threadIdx.x == 0) (void)xb_add(&bar[XB_XCNT(b.x)], 1u);
    return b;
}
__device__ __forceinline__ void xcd_barrier_complete(unsigned* bar, unsigned x, unsigned& nloc, unsigned& nx) {
    const unsigned G = gridDim.x * gridDim.y * gridDim.z;
    unsigned sum, cnt, mine, sp = 0u;
    for (;;) {
        sum = 0u; cnt = 0u; mine = 0u;
#pragma unroll
        for (unsigned j = 0; j < 16; ++j) { const unsigned c = xb_ld(&bar[XB_XCNT(j)]); sum += c; cnt += (c > 0u) ? 1u : 0u; mine = (j == x) ? c : mine; }
        if (sum == G) break;
        __builtin_amdgcn_s_sleep(1);
        if ((++sp & 255u) == 0u) { if (xb_ld(&bar[XB_TMO])) break; if (sp > XB_SPIN_CAP) { atomicAdd(&bar[XB_TMO], 1u); break; } }
    }
    nloc = mine > 0u ? mine : 1u; nx = cnt > 0u ? cnt : 1u;
}

__device__ __forceinline__ void xcd_barrier(const XcdBarrier& b) {
    asm volatile("s_waitcnt vmcnt(0)" ::: "memory");
    __syncthreads();
    if (threadIdx.x == 0) {
        unsigned* bar = b.bar;
        __builtin_amdgcn_s_waitcnt(0);
        unsigned nloc = b.st[0], nx = b.st[1];
        if (nloc == 0u) { xcd_barrier_complete(bar, b.x, nloc, nx); b.st[0] = nloc; b.st[1] = nx; }
        const unsigned old = xb_add(&bar[XB_XSUB(b.x)], 1u);
        const unsigned gen = old / nloc;
        if (old + 1u == (gen + 1u) * nloc) {
            __builtin_amdgcn_fence(__ATOMIC_RELEASE, "agent");
            asm volatile("s_waitcnt vmcnt(0)" ::: "memory");
            const unsigned og = xb_add(&bar[XB_TOP], 1u);
            const unsigned tg = og / nx;
            if (og + 1u == (tg + 1u) * nx) xb_add(&bar[XB_TOPGEN], 1u);
            else XB_SPIN(xb_ld(&bar[XB_TOPGEN]) == tg, bar);
            __builtin_amdgcn_fence(__ATOMIC_ACQUIRE, "agent");
            xb_add(&bar[XB_XGEN(b.x)], 1u);
            asm volatile("s_waitcnt vmcnt(0)" ::: "memory");
        } else {
            XB_SPIN(xb_ld(&bar[XB_XGEN(b.x)]) == gen, bar);
            __builtin_amdgcn_fence(__ATOMIC_ACQUIRE, "agent");
            asm volatile("s_waitcnt vmcnt(0)" ::: "memory");
        }
    }
    __syncthreads();
}

constexpr int SEQ = 8192, NBATCH = 2, M = NBATCH * SEQ, DM = 1024, FF = 4096;
constexpr int NIN = 4352;
constexpr float EPS = 1e-6f;
constexpr float LOG2E = 1.4426950408889634f;
constexpr float C_A = 0.125f * LOG2E;
constexpr float C_B = 0.10206207261596575f * LOG2E;
constexpr size_t MiB = 1u << 20;
constexpr size_t WS_BAR = 512 * 1024, WS_BAR_BYTES = 16384;
constexpr size_t WS_ROWSS_Q = 0, WS_ROWSS_KV = 65536, WS_ROWSS2 = 131072, WS_KMEAN = 196608, WS_CTL_END = 327680;
constexpr size_t WS_WIN = 1 * MiB, WS_WQUP = 10 * MiB, WS_WKVUP = 11 * MiB, WS_WOA = 12 * MiB, WS_WOB = 13 * MiB, WS_WOUT = 14 * MiB, WS_WFF1 = 16 * MiB, WS_WFF2 = 24 * MiB;
constexpr size_t WS_ROPE64 = 32 * MiB, WS_ROPE32 = 34 * MiB;
constexpr size_t WS_XN = 36 * MiB, WS_OA = 36 * MiB, WS_OB = 52 * MiB, WS_X1B = 36 * MiB;
constexpr size_t WS_QA = 68 * MiB, WS_KA = 84 * MiB, WS_VA = 100 * MiB, WS_CQ = 116 * MiB, WS_CKV = 128 * MiB, WS_QB = 138 * MiB, WS_KB = 162 * MiB, WS_VB = 186 * MiB;
constexpr size_t WS_Z = 68 * MiB, WS_U = 68 * MiB, WS_END = 202 * MiB;
constexpr int LDS_BYTES = 147456;
constexpr int NTHREADS = 512;

typedef float f32x2_t __attribute__((ext_vector_type(2))); typedef __bf16 bf16x2_t __attribute__((ext_vector_type(2)));
__device__ __forceinline__ unsigned cvtpk(float lo, float hi) { f32x2_t v = {lo, hi}; bf16x2_t b = __builtin_convertvector(v, bf16x2_t); return __builtin_bit_cast(unsigned, b); }
__device__ __forceinline__ void st4(bf16_t* p, f32x4 v) { u32x2 w; w.x = cvtpk(v[0], v[1]); w.y = cvtpk(v[2], v[3]); *(u32x2*)p = w; }
__device__ __forceinline__ float bf2f(unsigned short s) { return __uint_as_float(((unsigned)s) << 16); }
__device__ __forceinline__ f32x4 ld4bf(const bf16_t* p) { const u32x2 w = *(const u32x2*)p; return (f32x4){__uint_as_float(w.x << 16), __uint_as_float(w.x & 0xffff0000u), __uint_as_float(w.y << 16), __uint_as_float(w.y & 0xffff0000u)}; }
__device__ __forceinline__ float wave_sum(float v) {
#pragma unroll
    for (int o = 1; o < 64; o <<= 1) v += __shfl_xor(v, o);
    return v;
}

#define EPI_ROWS(ai, m) for (int ai = 0; ai < 2; ++ai) _Pragma("unroll") for (int m = 0; m < 4; ++m)

struct EpiProj {
    static constexpr bool PERM = false, AFTER_DRAIN = false;
    bf16_t *QA, *KA, *VA, *CQ, *CKV, *KB, *G; float *ROWSS_Q, *ROWSS_KV, *KMEAN; const float *ROPE64, *ROPE32, *b_gate;
    __device__ __forceinline__ void operator()(const f32x4 (&acc)[2][2][4][2], const pg8::Unit& u, int wr, int wc, int fr, int fq) const {
        const int pn = u.pn; const int row0 = u.pm * 256 + wr * 64 + fr; const int cl = wc * 32 + 4 * fq;
        if (pn < 4) {
            bf16_t* dst = pn < 2 ? QA : KA; const int cbase = (pn & 1) * 256; const float sc = pn < 2 ? C_A : 1.f; const int fi = 16 * (wc & 1) + 4 * fq;
            f32x4 ks[2][2];
#pragma unroll
            for (int bj = 0; bj < 2; ++bj) { ks[bj][0] = (f32x4){0.f, 0.f, 0.f, 0.f}; ks[bj][1] = (f32x4){0.f, 0.f, 0.f, 0.f}; }
#pragma unroll
            EPI_ROWS(ai, m) {
                const int row = row0 + 128 * ai + 16 * m; const int pos = row & (SEQ - 1);
                const f32x4* rp = (const f32x4*)(ROPE64 + ((size_t)pos * 32 + fi) * 2); const f32x4 r01 = rp[0], r23 = rp[1];
                const f32x4 c = (f32x4){r01[0], r01[2], r23[0], r23[2]}, s = (f32x4){r01[1], r01[3], r23[1], r23[3]};
#pragma unroll
                for (int bj = 0; bj < 2; ++bj) {
                    const f32x4 x1 = acc[ai][bj][m][0], x2 = acc[ai][bj][m][1];
                    const f32x4 o1 = x1 * c - x2 * s, o2 = x2 * c + x1 * s;
                    ks[bj][0] += o1; ks[bj][1] += o2;
                    bf16_t* p = dst + (size_t)row * 512 + cbase + 128 * bj + cl;
                    st4(p, o1 * sc); st4(p + 16, o2 * sc);
                }
            }
            if (pn >= 2) {
#pragma unroll
                for (int bj = 0; bj < 2; ++bj)
#pragma unroll
                    for (int n = 0; n < 2; ++n)
#pragma unroll
                        for (int j = 0; j < 4; ++j) { float v = ks[bj][n][j]; v += __shfl_xor(v, 1); v += __shfl_xor(v, 2); v += __shfl_xor(v, 4); v += __shfl_xor(v, 8);
                            if (fr == 0) unsafeAtomicAdd(KMEAN + (size_t)u.pm * 512 + cbase + 128 * bj + cl + 16 * n + j, v * (1.f / 256.f)); }
            }
        } else if (pn < 6) {
            const int cbase = (pn - 4) * 256;
#pragma unroll
            EPI_ROWS(ai, m) { const int row = row0 + 128 * ai + 16 * m;
#pragma unroll
                for (int bj = 0; bj < 2; ++bj)
#pragma unroll
                    for (int n = 0; n < 2; ++n) st4(VA + (size_t)row * 512 + cbase + 128 * bj + cl + 16 * n, acc[ai][bj][m][n]); }
        } else if (pn < 9) {
#pragma unroll
            EPI_ROWS(ai, m) { const int row = row0 + 128 * ai + 16 * m; float sq = 0.f, skv = 0.f;
#pragma unroll
                for (int bj = 0; bj < 2; ++bj) {
                    const f32x4 v0 = acc[ai][bj][m][0], v1 = acc[ai][bj][m][1];
                    const float ss = (v0[0] * v0[0] + v0[1] * v0[1]) + (v0[2] * v0[2] + v0[3] * v0[3]) + (v1[0] * v1[0] + v1[1] * v1[1]) + (v1[2] * v1[2] + v1[3] * v1[3]);
                    const int sel = (pn - 6) * 2 + bj;
                    if (sel < 3) { sq += ss; bf16_t* p = CQ + (size_t)row * 384 + 128 * sel + cl; st4(p, v0); st4(p + 16, v1); }
                    else if (sel < 5) { skv += ss; bf16_t* p = CKV + (size_t)row * 256 + 128 * (sel - 3) + cl; st4(p, v0); st4(p + 16, v1); }
                    else if (wc == 0) {
                        const int pos = row & (SEQ - 1);
                        const f32x4* rp = (const f32x4*)(ROPE32 + ((size_t)pos * 16 + 4 * fq) * 2); const f32x4 r01 = rp[0], r23 = rp[1];
                        const f32x4 c = (f32x4){r01[0], r01[2], r23[0], r23[2]}, s = (f32x4){r01[1], r01[3], r23[1], r23[3]};
                        const f32x4 o1 = v0 * c - v1 * s, o2 = v1 * c + v0 * s;
#pragma unroll
                        for (int h = 0; h < 8; ++h) { bf16_t* p = KB + (size_t)row * 768 + 96 * h + 64 + 4 * fq; st4(p, o1); st4(p + 16, o2); }
                    }
                }
                if (pn < 8) { sq += __shfl_xor(sq, 16); sq += __shfl_xor(sq, 32); if (fq == 0) unsafeAtomicAdd(ROWSS_Q + row, sq); }
                if (pn > 6) { skv += __shfl_xor(skv, 16); skv += __shfl_xor(skv, 32); if (fq == 0) unsafeAtomicAdd(ROWSS_KV + row, skv); }
            }
        } else {
            const int gbase = (pn - 9) * 256;
#pragma unroll
            for (int bj = 0; bj < 2; ++bj)
#pragma unroll
                for (int n = 0; n < 2; ++n) {
                    const int gc = gbase + 128 * bj + cl + 16 * n; const f32x4 bv = *(const f32x4*)(b_gate + gc);
                    bf16_t* dst = G + (size_t)(gc >> 10) * ((size_t)M * 1024) + (gc & 1023);
#pragma unroll
                    EPI_ROWS(ai, m) { const int row = row0 + 128 * ai + 16 * m; f32x4 v = acc[ai][bj][m][n] + bv;
#pragma unroll
                        for (int j = 0; j < 4; ++j) v[j] = __builtin_amdgcn_rcpf(1.f + __builtin_amdgcn_exp2f(-LOG2E * v[j]));
                        st4(dst + (size_t)row * 1024, v); }
                }
        }
    }
};
struct EpiQup {
    static constexpr bool PERM = false, AFTER_DRAIN = false;
    bf16_t* QB; const float *ROWSS_Q, *ROPE32;
    __device__ __forceinline__ void operator()(const f32x4 (&acc)[2][2][4][2], const pg8::Unit& u, int wr, int wc, int fr, int fq) const {
        const int row0 = u.pm * 256 + wr * 64 + fr;
#pragma unroll
        EPI_ROWS(ai, m) { const int row = row0 + 128 * ai + 16 * m; const float rs = rsqrtf(ROWSS_Q[row] * (1.f / 384.f) + EPS) * C_B; const int pos = row & (SEQ - 1);
#pragma unroll
            for (int bj = 0; bj < 2; ++bj) {
                const int grp = 8 * u.pn + 4 * bj + wc; const int part = grp % 3;
                f32x4 v0 = acc[ai][bj][m][0] * rs, v1 = acc[ai][bj][m][1] * rs;
                if (part == 2) {
                    const f32x4* rp = (const f32x4*)(ROPE32 + ((size_t)pos * 16 + 4 * fq) * 2); const f32x4 r01 = rp[0], r23 = rp[1];
                    const f32x4 c = (f32x4){r01[0], r01[2], r23[0], r23[2]}, s = (f32x4){r01[1], r01[3], r23[1], r23[3]};
                    const f32x4 o1 = v0 * c - v1 * s, o2 = v1 * c + v0 * s; v0 = o1; v1 = o2;
                }
                bf16_t* p = QB + (size_t)row * 768 + 32 * grp + 4 * fq; st4(p, v0); st4(p + 16, v1);
            } }
    }
};
struct EpiKVup {
    static constexpr bool PERM = false, AFTER_DRAIN = false;
    bf16_t *KB, *VB; const float* ROWSS_KV;
    __device__ __forceinline__ void operator()(const f32x4 (&acc)[2][2][4][2], const pg8::Unit& u, int wr, int wc, int fr, int fq) const {
        const int row0 = u.pm * 256 + wr * 64 + fr;
#pragma unroll
        EPI_ROWS(ai, m) { const int row = row0 + 128 * ai + 16 * m; const float rs = rsqrtf(ROWSS_KV[row] * (1.f / 256.f) + EPS);
#pragma unroll
            for (int bj = 0; bj < 2; ++bj) { const int head = 2 * u.pn + bj;
                bf16_t* p = (wc < 2) ? KB + (size_t)row * 768 + 96 * head + 32 * wc + 4 * fq : VB + (size_t)row * 512 + 64 * head + 32 * (wc - 2) + 4 * fq;
                st4(p, acc[ai][bj][m][0] * rs); st4(p + 16, acc[ai][bj][m][1] * rs); } }
    }
};
template <bool ADD> struct EpiGate {
    static constexpr bool PERM = false, AFTER_DRAIN = false;
    bf16_t* Z; const bf16_t* Gt;
    __device__ __forceinline__ void operator()(const f32x4 (&acc)[2][2][4][2], const pg8::Unit& u, int wr, int wc, int fr, int fq) const {
        const int row0 = u.pm * 256 + wr * 64 + fr; const int col0 = u.pn * 256 + wc * 32 + 4 * fq;
#pragma unroll
        EPI_ROWS(ai, m) { const size_t ro = (size_t)(row0 + 128 * ai + 16 * m) * 1024 + col0;
#pragma unroll
            for (int bj = 0; bj < 2; ++bj)
#pragma unroll
                for (int n = 0; n < 2; ++n) { const size_t o = ro + 128 * bj + 16 * n; f32x4 v = acc[ai][bj][m][n] * ld4bf(Gt + o); if (ADD) v += ld4bf(Z + o); st4(Z + o, v); } }
    }
};
struct EpiOut {
    static constexpr bool PERM = false, AFTER_DRAIN = false;
    const float* X; float* X1; bf16_t* X1B; float* ROWSS2;
    __device__ __forceinline__ void operator()(const f32x4 (&acc)[2][2][4][2], const pg8::Unit& u, int wr, int wc, int fr, int fq) const {
        const int row0 = u.pm * 256 + wr * 64 + fr; const int col0 = u.pn * 256 + wc * 32 + 4 * fq;
#pragma unroll
        EPI_ROWS(ai, m) { const int row = row0 + 128 * ai + 16 * m; const size_t ro = (size_t)row * 1024 + col0; float ss = 0.f;
#pragma unroll
            for (int bj = 0; bj < 2; ++bj)
#pragma unroll
                for (int n = 0; n < 2; ++n) { const size_t o = ro + 128 * bj + 16 * n; const f32x4 v = acc[ai][bj][m][n] + *(const f32x4*)(X + o);
                    ss += (v[0] * v[0] + v[1] * v[1]) + (v[2] * v[2] + v[3] * v[3]); *(f32x4*)(X1 + o) = v; st4(X1B + o, v); }
            ss += __shfl_xor(ss, 16); ss += __shfl_xor(ss, 32); if (fq == 0) unsafeAtomicAdd(ROWSS2 + row, ss); }
    }
};
struct EpiFF1 {
    static constexpr bool PERM = false, AFTER_DRAIN = false;
    bf16_t* U; const float* ROWSS2;
    __device__ __forceinline__ void operator()(const f32x4 (&acc)[2][2][4][2], const pg8::Unit& u, int wr, int wc, int fr, int fq) const {
        const int row0 = u.pm * 256 + wr * 64 + fr; const int col0 = u.pn * 256 + wc * 32 + 4 * fq;
#pragma unroll
        EPI_ROWS(ai, m) { const int row = row0 + 128 * ai + 16 * m; const float r2 = 1.f / (ROWSS2[row] * (1.f / 1024.f) + EPS);
#pragma unroll
            for (int bj = 0; bj < 2; ++bj)
#pragma unroll
                for (int n = 0; n < 2; ++n) { f32x4 v = acc[ai][bj][m][n];
#pragma unroll
                    for (int j = 0; j < 4; ++j) { const float t = fmaxf(v[j], 0.f); v[j] = t * t * r2; }
                    st4(U + (size_t)row * FF + col0 + 128 * bj + 16 * n, v); } }
    }
};
struct EpiFF2 {
    static constexpr bool PERM = false, AFTER_DRAIN = false;
    float* X1;
    __device__ __forceinline__ void operator()(const f32x4 (&acc)[2][2][4][2], const pg8::Unit& u, int wr, int wc, int fr, int fq) const {
        const int row0 = u.pm * 256 + wr * 64 + fr; const int col0 = u.pn * 256 + wc * 32 + 4 * fq;
#pragma unroll
        EPI_ROWS(ai, m) { const size_t ro = (size_t)(row0 + 128 * ai + 16 * m) * 1024 + col0;
#pragma unroll
            for (int bj = 0; bj < 2; ++bj)
#pragma unroll
                for (int n = 0; n < 2; ++n) { float* p = X1 + ro + 128 * bj + 16 * n; *(f32x4*)p = *(const f32x4*)p + acc[ai][bj][m][n]; } }
    }
};

__device__ __forceinline__ int crow(int r, int hi) { return (r & 3) + 8 * (r >> 2) + 4 * hi; }
template <int DQK, bool MOBA>
__device__ __forceinline__ void attn_unit(int b, int h, int qb, const bf16_t* __restrict__ Qg, const bf16_t* __restrict__ Kg, const bf16_t* __restrict__ Vg, bf16_t* __restrict__ Og,
                                          const float* __restrict__ kmean, LAS unsigned char* lds) {
    constexpr int LDQ = 8 * DQK, ND = DQK / 16, KP = DQK * 2 + 16, VP = 144, KBYTES = 64 * KP, VBYTES = 64 * VP, VOFF = 2 * KBYTES, CTLOFF = 2 * KBYTES + 2 * VBYTES;
    constexpr int KCH = DQK / 8;
    LAS unsigned* uni = (LAS unsigned*)(lds + CTLOFF);
    LAS int* tl = (LAS int*)(lds + CTLOFF + 64);
    int tid_ = threadIdx.x; asm volatile("" : "+v"(tid_));
    const int tid = tid_, lane = tid & 63, wid = __builtin_amdgcn_readfirstlane(tid >> 6), r32 = lane & 31, hi = lane >> 5;
    const size_t rowbase = (size_t)b * SEQ; const int q0 = qb * 256;
    bf16x8 qf[ND];
    { const bf16_t* qrow = Qg + (rowbase + q0 + wid * 32 + r32) * LDQ + h * DQK + 8 * hi;
#pragma unroll
      for (int d0 = 0; d0 < ND; ++d0) qf[d0] = *(const bf16x8*)(qrow + 16 * d0); }
    unsigned selmask = 0u;
    if constexpr (MOBA) {
        float v1 = -INFINITY, v2 = -INFINITY, v3 = -INFINITY; int i1 = -1, i2 = -1, i3 = -1;
        for (int j = 0; j < qb; ++j) {
            const float* km = kmean + (size_t)(b * 32 + j) * 512 + h * 64 + 8 * hi; float s = 0.f;
#pragma unroll
            for (int d0 = 0; d0 < 4; ++d0) { const f32x4 a = *(const f32x4*)(km + 16 * d0), c = *(const f32x4*)(km + 16 * d0 + 4);
                s += bf2f((unsigned short)qf[d0][0]) * a[0] + bf2f((unsigned short)qf[d0][1]) * a[1] + bf2f((unsigned short)qf[d0][2]) * a[2] + bf2f((unsigned short)qf[d0][3]) * a[3]
                   + bf2f((unsigned short)qf[d0][4]) * c[0] + bf2f((unsigned short)qf[d0][5]) * c[1] + bf2f((unsigned short)qf[d0][6]) * c[2] + bf2f((unsigned short)qf[d0][7]) * c[3]; }
            s += __shfl_xor(s, 32);
            if (s > v1) { v3 = v2; i3 = i2; v2 = v1; i2 = i1; v1 = s; i1 = j; }
            else if (s > v2) { v3 = v2; i3 = i2; v2 = s; i2 = j; }
            else if (s > v3) { v3 = s; i3 = j; }
        }
        if (i1 >= 0) selmask |= 1u << i1; if (i2 >= 0) selmask |= 1u << i2; if (i3 >= 0) selmask |= 1u << i3;
        unsigned um = selmask;
#pragma unroll
        for (int o = 1; o < 64; o <<= 1) um |= (unsigned)__shfl_xor((int)um, o);
        if (lane == 0) uni[wid] = um;
        __syncthreads();
    }
    unsigned um;
    if constexpr (MOBA) { um = 0u;
#pragma unroll
        for (int w = 0; w < 8; ++w) um |= uni[w]; um = (unsigned)__builtin_amdgcn_readfirstlane((int)um); }
    else um = (qb == 0) ? 0u : (0xffffffffu >> (32 - qb));
    const int nblk = __builtin_popcount(um); const int nt = 4 * (nblk + 1);
    if (tid < 32) { if ((um >> tid) & 1u) { const int idx = __builtin_popcount(um & ((1u << tid) - 1u));
#pragma unroll
            for (int s = 0; s < 4; ++s) tl[4 * idx + s] = 256 * tid + 64 * s; } }
    else if (tid == 32) {
#pragma unroll
        for (int s = 0; s < 4; ++s) tl[4 * nblk + s] = q0 + 64 * s; }
    __syncthreads();
    const int kr0 = (KCH == 8) ? (tid >> 3) : (tid / 12), kc0 = (KCH == 8) ? (tid & 7) : (tid % 12);
    const int kr1 = (tid + 512) / 12, kc1 = (tid + 512) % 12; const bool has2 = (KCH == 12) && (tid < 256); const int kr1c = has2 ? kr1 : kr0;
    const bf16_t* Kh = Kg + rowbase * LDQ + h * DQK; const bf16_t* Vh = Vg + rowbase * 512 + h * 64;
    const int vkv = tid & 63, vdg = tid >> 6;
    const int vpos = (vkv & ~15) | (((vkv >> 2) & 1) << 3) | (((vkv >> 3) & 1) << 2) | (vkv & 3);
    u32x4 kA0, kA1 = (u32x4){0u, 0u, 0u, 0u}, vA, kB0, kB1 = (u32x4){0u, 0u, 0u, 0u}, vB;
#define ATT_LOADK(K0, K1, kv0) do { K0 = *(const u32x4*)(Kh + (size_t)((kv0) + kr0) * LDQ + 8 * kc0); if constexpr (KCH == 12) K1 = *(const u32x4*)(Kh + (size_t)((kv0) + kr1c) * LDQ + 8 * kc1); } while (0)
#define ATT_LOADV(V_, kv0) do { V_ = *(const u32x4*)(Vh + (size_t)((kv0) + vkv) * 512 + 8 * vdg); } while (0)
#define ATT_STOREK(K0, K1, buf) do { LAS unsigned char* kb_ = lds + (buf) * KBYTES; *(LAS u32x4*)(kb_ + kr0 * KP + 16 * kc0) = K0; if (has2) *(LAS u32x4*)(kb_ + kr1 * KP + 16 * kc1) = K1; } while (0)
#define ATT_STOREV(V_, buf) do { LAS unsigned char* vb_ = lds + VOFF + (buf) * VBYTES + (8 * vdg) * VP + 2 * vpos; \
        *(LAS unsigned short*)(vb_ + 0 * VP) = (unsigned short)(V_.x & 0xffffu); *(LAS unsigned short*)(vb_ + 1 * VP) = (unsigned short)(V_.x >> 16); \
        *(LAS unsigned short*)(vb_ + 2 * VP) = (unsigned short)(V_.y & 0xffffu); *(LAS unsigned short*)(vb_ + 3 * VP) = (unsigned short)(V_.y >> 16); \
        *(LAS unsigned short*)(vb_ + 4 * VP) = (unsigned short)(V_.z & 0xffffu); *(LAS unsigned short*)(vb_ + 5 * VP) = (unsigned short)(V_.z >> 16); \
        *(LAS unsigned short*)(vb_ + 6 * VP) = (unsigned short)(V_.w & 0xffffu); *(LAS unsigned short*)(vb_ + 7 * VP) = (unsigned short)(V_.w >> 16); } while (0)
#define ATT_QK(S0, S1, kbuf) do { const LAS unsigned char* kb_ = lds + (kbuf) * KBYTES + r32 * KP + (8 * hi) * 2; \
        S0 = __builtin_amdgcn_mfma_f32_32x32x16_bf16(*(const LAS bf16x8*)(kb_), qf[0], cinit, 0, 0, 0); \
        S1 = __builtin_amdgcn_mfma_f32_32x32x16_bf16(*(const LAS bf16x8*)(kb_ + 32 * KP), qf[0], cinit, 0, 0, 0); \
        _Pragma("unroll") for (int d0 = 1; d0 < ND; ++d0) { \
            S0 = __builtin_amdgcn_mfma_f32_32x32x16_bf16(*(const LAS bf16x8*)(kb_ + 32 * d0), qf[d0], S0, 0, 0, 0); \
            S1 = __builtin_amdgcn_mfma_f32_32x32x16_bf16(*(const LAS bf16x8*)(kb_ + 32 * KP + 32 * d0), qf[d0], S1, 0, 0, 0); } } while (0)
    f32x16 o0, o1, cinit;
#pragma unroll
    for (int r = 0; r < 16; ++r) { o0[r] = 0.f; o1[r] = 0.f; cinit[r] = 0.f; }
    float lrun = 0.f, negm = 0.f; bool started = false; int curblk = -1;
#define ATT_CINIT(kvpos) do { if constexpr (MOBA) { const int blk_ = (kvpos) >> 8; if (blk_ != curblk) { curblk = blk_; const float cv_ = (blk_ == qb || ((selmask >> blk_) & 1u)) ? negm : -INFINITY; \
        _Pragma("unroll") for (int r = 0; r < 16; ++r) cinit[r] = cv_; } } } while (0)
    ATT_LOADK(kA0, kA1, tl[0]); ATT_LOADV(vA, tl[0]); ATT_STOREK(kA0, kA1, 0); ATT_STOREV(vA, 0);
    ATT_LOADK(kA0, kA1, tl[1]);
    __syncthreads();
    f32x16 s0, s1;
    ATT_CINIT(tl[0]);
    ATT_QK(s0, s1, 0);
    ATT_STOREK(kA0, kA1, 1);
    ATT_LOADK(kB0, kB1, tl[2]); ATT_LOADV(vB, tl[1]);
    __syncthreads();
    auto body = [&](const int it, u32x4& LK0, u32x4& LK1, u32x4& LV, const u32x4& SK0, const u32x4& SK1, const u32x4& SV) __attribute__((always_inline)) {
        const int kv0 = tl[it]; const bool diag = ((kv0 >> 8) == qb);
        const bool n1 = (it + 1 < nt);
        { const int kvk = tl[(it + 3 < nt) ? it + 3 : nt - 1], kvv = tl[(it + 2 < nt) ? it + 2 : nt - 1]; ATT_LOADK(LK0, LK1, kvk); ATT_LOADV(LV, kvv); }
        if (diag) { const int qrel = 32 * wid + r32 - (kv0 - q0);
#pragma unroll
            for (int r = 0; r < 16; ++r) { const int kvr = crow(r, hi); if (kvr > qrel) s0[r] = -INFINITY; if (kvr + 32 > qrel) s1[r] = -INFINITY; } }
        float mxa = __builtin_fmaxf(__builtin_fmaxf(s0[0], s0[1]), s1[0]), mxb = __builtin_fmaxf(__builtin_fmaxf(s0[2], s0[3]), s1[1]);
        mxa = __builtin_fmaxf(__builtin_fmaxf(mxa, s1[2]), s1[3]);
#pragma unroll
        for (int r = 4; r < 16; r += 4) { mxa = __builtin_fmaxf(__builtin_fmaxf(mxa, s0[r]), s0[r + 1]); mxb = __builtin_fmaxf(__builtin_fmaxf(mxb, s0[r + 2]), s0[r + 3]);
            mxa = __builtin_fmaxf(__builtin_fmaxf(mxa, s1[r]), s1[r + 1]); mxb = __builtin_fmaxf(__builtin_fmaxf(mxb, s1[r + 2]), s1[r + 3]); }
        float mx = __builtin_fmaxf(mxa, mxb);
        { auto rr = __builtin_amdgcn_permlane32_swap(__float_as_uint(mx), __float_as_uint(mx), false, false); mx = __builtin_fmaxf(__uint_as_float(rr[0]), __uint_as_float(rr[1])); }
        const bool need = started ? (mx > 8.f) : (mx > -INFINITY);
        if (__any(need)) {
            const float dl = need ? mx : 0.f; started = started || need;
            negm -= dl;
#pragma unroll
            for (int r = 0; r < 16; ++r) { s0[r] -= dl; s1[r] -= dl; cinit[r] -= dl; }
            const float alpha = __builtin_amdgcn_exp2f(-dl); lrun *= alpha;
#pragma unroll
            for (int r = 0; r < 16; ++r) { o0[r] *= alpha; o1[r] *= alpha; }
        }
        f32x16 t0, t1;
        { const int kvn = n1 ? tl[it + 1] : kv0; ATT_CINIT(kvn); }
        ATT_QK(t0, t1, (it + 1) & 1);
        f32x2_t ls2 = {0.f, 0.f};
#pragma unroll
        for (int r = 0; r < 16; ++r) { s0[r] = __builtin_amdgcn_exp2f(s0[r]); s1[r] = __builtin_amdgcn_exp2f(s1[r]); }
#pragma unroll
        for (int r = 0; r < 16; r += 2) { ls2 += (f32x2_t){s0[r], s0[r + 1]}; ls2 += (f32x2_t){s1[r], s1[r + 1]}; }
        lrun += ls2.x + ls2.y;
        const LAS unsigned char* vb = lds + VOFF + (it & 1) * VBYTES;
#pragma unroll
        for (int kt = 0; kt < 2; ++kt)
#pragma unroll
            for (int uu = 0; uu < 2; ++uu) {
                u32x4 pw;
                if (kt == 0) { pw.x = cvtpk(s0[8 * uu + 0], s0[8 * uu + 1]); pw.y = cvtpk(s0[8 * uu + 2], s0[8 * uu + 3]); pw.z = cvtpk(s0[8 * uu + 4], s0[8 * uu + 5]); pw.w = cvtpk(s0[8 * uu + 6], s0[8 * uu + 7]); }
                else         { pw.x = cvtpk(s1[8 * uu + 0], s1[8 * uu + 1]); pw.y = cvtpk(s1[8 * uu + 2], s1[8 * uu + 3]); pw.z = cvtpk(s1[8 * uu + 4], s1[8 * uu + 5]); pw.w = cvtpk(s1[8 * uu + 6], s1[8 * uu + 7]); }
                const bf16x8 pb = __builtin_bit_cast(bf16x8, pw);
                const int kvo = (32 * kt + 16 * uu + 8 * hi) * 2;
#pragma unroll
                for (int dt = 0; dt < 2; ++dt) {
                    const bf16x8 va = *(const LAS bf16x8*)(vb + (32 * dt + r32) * VP + kvo);
                    if (dt == 0) o0 = __builtin_amdgcn_mfma_f32_32x32x16_bf16(va, pb, o0, 0, 0, 0); else o1 = __builtin_amdgcn_mfma_f32_32x32x16_bf16(va, pb, o1, 0, 0, 0);
                }
            }
        ATT_STOREK(SK0, SK1, it & 1);
        ATT_STOREV(SV, (it + 1) & 1);
        __syncthreads();
        s0 = t0; s1 = t1;
    };
    for (int it = 0; it < nt; it += 2) { body(it, kA0, kA1, vA, kB0, kB1, vB); body(it + 1, kB0, kB1, vB, kA0, kA1, vA); }
#undef ATT_LOADK
#undef ATT_LOADV
#undef ATT_STOREK
#undef ATT_STOREV
#undef ATT_QK
#undef ATT_CINIT
    lrun += __shfl_xor(lrun, 32);
    const float inv = 1.f / lrun;
    bf16_t* orow = Og + (rowbase + q0 + wid * 32 + r32) * 512 + h * 64 + 4 * hi;
#pragma unroll
    for (int g = 0; g < 4; ++g) {
        st4(orow + 8 * g, (f32x4){o0[4 * g] * inv, o0[4 * g + 1] * inv, o0[4 * g + 2] * inv, o0[4 * g + 3] * inv});
        st4(orow + 32 + 8 * g, (f32x4){o1[4 * g] * inv, o1[4 * g + 1] * inv, o1[4 * g + 2] * inv, o1[4 * g + 3] * inv});
    }
}

__device__ __forceinline__ int win_src_col(int p) {
    if (p < 1024) { const int base = p & ~63, w = p & 63, g = w >> 5, ww = w & 31; return base + (ww < 16 ? 16 * g + ww : 32 + 16 * g + (ww - 16)); }
    if (p < 2208) return p;
    if (p < 2304) return -1;
    return p - 96;
}
__device__ __forceinline__ void transpose_item(const float* __restrict__ W, int K, int Nsrc, int nblk, bf16_t* WT, const float* gk, bool winmap, LAS float* scr, int item, int lane) {
    const int kb = item / nblk, nb = item % nblk, k0 = 64 * kb, n0 = 32 * nb;
    const int np = n0 + (lane & 31); const int sc = winmap ? win_src_col(np) : np;
#pragma unroll 8
    for (int i = 0; i < 32; ++i) { const int kk = 2 * i + (lane >> 5); float v = (sc >= 0) ? W[(size_t)(k0 + kk) * Nsrc + sc] : 0.f; if (gk) v *= gk[k0 + kk]; scr[kk * 33 + (lane & 31)] = v; }
    asm volatile("s_waitcnt lgkmcnt(0)" ::: "memory");
    const int c = lane & 7;
#pragma unroll
    for (int j = 0; j < 4; ++j) { const int n = (lane >> 3) + 8 * j; const LAS float* s = scr + (8 * c) * 33 + n;
        u32x4 o; o.x = cvtpk(s[0 * 33], s[1 * 33]); o.y = cvtpk(s[2 * 33], s[3 * 33]); o.z = cvtpk(s[4 * 33], s[5 * 33]); o.w = cvtpk(s[6 * 33], s[7 * 33]);
        *(u32x4*)(WT + (size_t)(n0 + n) * K + k0 + 8 * c) = o; }
    asm volatile("s_waitcnt lgkmcnt(0)" ::: "memory");
}

#define GRID_SYNC() xcd_barrier(xbar)
struct Args { const float* in[15]; float* out; unsigned char* ws; };

__global__ void __launch_bounds__(NTHREADS, 2) fwd_megakernel(Args a) {
    extern __shared__ __attribute__((aligned(16))) unsigned char lds_raw[];
    LAS unsigned char* lds = (LAS unsigned char*)lds_raw;
    cg::grid_group grid = cg::this_grid();
    if (a.ws == nullptr) grid.sync();
    volatile LAS unsigned* MISC = (volatile LAS unsigned*)(lds + 131072 + 320);
    if (threadIdx.x < 32) MISC[threadIdx.x] = 0u;
    __syncthreads();
    XcdBarrier xbar = xcd_barrier_post((unsigned*)(a.ws + WS_BAR), MISC + 8);
    const int G = gridDim.x, bx = blockIdx.x; const int vcu = (G % 8 == 0) ? (bx % 8) * (G / 8) + bx / 8 : bx;
    unsigned char* ws = a.ws;
    const float *x = a.in[0], *g_mix = a.in[1], *w_in = a.in[2], *b_gate = a.in[3], *g_cq = a.in[4], *w_q_up = a.in[5], *g_ckv = a.in[6], *w_kv_up = a.in[7],
                *w_o_a = a.in[8], *w_o_b = a.in[9], *w_out = a.in[10], *g_mlp = a.in[11], *w_ff1 = a.in[12], *w_ff2 = a.in[13], *g_final = a.in[14];
    float* out = a.out;
    float *ROWSS_Q = (float*)(ws + WS_ROWSS_Q), *ROWSS_KV = (float*)(ws + WS_ROWSS_KV), *ROWSS2 = (float*)(ws + WS_ROWSS2), *KMEAN = (float*)(ws + WS_KMEAN);
    bf16_t *WIN = (bf16_t*)(ws + WS_WIN), *WQUP = (bf16_t*)(ws + WS_WQUP), *WKVUP = (bf16_t*)(ws + WS_WKVUP), *WOA = (bf16_t*)(ws + WS_WOA), *WOB = (bf16_t*)(ws + WS_WOB),
           *WOUT = (bf16_t*)(ws + WS_WOUT), *WFF1 = (bf16_t*)(ws + WS_WFF1), *WFF2 = (bf16_t*)(ws + WS_WFF2);
    float *ROPE64 = (float*)(ws + WS_ROPE64), *ROPE32 = (float*)(ws + WS_ROPE32);
    bf16_t *XN = (bf16_t*)(ws + WS_XN), *OA = (bf16_t*)(ws + WS_OA), *OB = (bf16_t*)(ws + WS_OB), *X1B = (bf16_t*)(ws + WS_X1B);
    bf16_t *QA = (bf16_t*)(ws + WS_QA), *KA = (bf16_t*)(ws + WS_KA), *VA = (bf16_t*)(ws + WS_VA), *CQ = (bf16_t*)(ws + WS_CQ), *CKV = (bf16_t*)(ws + WS_CKV),
           *QB = (bf16_t*)(ws + WS_QB), *KB = (bf16_t*)(ws + WS_KB), *VB = (bf16_t*)(ws + WS_VB), *Z = (bf16_t*)(ws + WS_Z), *U = (bf16_t*)(ws + WS_U);
    bf16_t* GT = (bf16_t*)out;

#if defined(PROBE_P0)
    for (int rep_ = 0; rep_ < 2; ++rep_)
#endif
    {
        int tid_ = threadIdx.x; asm volatile("" : "+v"(tid_)); const int tid = tid_, lane = tid & 63, wave = __builtin_amdgcn_readfirstlane(tid >> 6);
        const int gw = vcu * 8 + wave, NGW = G * 8;
        const int gt = bx * NTHREADS + tid, NGT = G * NTHREADS;
        for (int i = gt; i < (int)(WS_CTL_END / 4); i += NGT) ((float*)ws)[i] = 0.f;
        for (int i = gt; i < SEQ * 32; i += NGT) { const int pos = i >> 5, f = i & 31; const float inv = __builtin_amdgcn_exp2f(-(float)f * (13.287712379549449f / 32.f)); const float ang = (float)pos * inv;
            double rev = (double)ang * 0.15915494309189535; rev -= __builtin_rint(rev); const float fr = (float)rev;
            ROPE64[2 * i] = __builtin_amdgcn_cosf(fr); ROPE64[2 * i + 1] = __builtin_amdgcn_sinf(fr); }
        for (int i = gt; i < SEQ * 16; i += NGT) { const int pos = i >> 4, f = i & 15; const float inv = __builtin_amdgcn_exp2f(-(float)f * (13.287712379549449f / 16.f)); const float ang = (float)pos * inv;
            double rev = (double)ang * 0.15915494309189535; rev -= __builtin_rint(rev); const float fr = (float)rev;
            ROPE32[2 * i] = __builtin_amdgcn_cosf(fr); ROPE32[2 * i + 1] = __builtin_amdgcn_sinf(fr); }
        LAS float* scr = (LAS float*)(lds + wave * 16384);
        constexpr int I_IN = 16 * 136, I_QUP = 6 * 24, I_KVUP = 4 * 32, I_OA = 8 * 32, I_OUT = 16 * 32, I_FF1 = 16 * 128, I_FF2 = 64 * 32;
        constexpr int NITEMS = I_IN + I_QUP + I_KVUP + 2 * I_OA + I_OUT + I_FF1 + I_FF2;
        for (int it = gw; it < NITEMS; it += NGW) {
            int r = it;
            if (r < I_IN) { transpose_item(w_in, 1024, 4256, 136, WIN, nullptr, true, scr, r, lane); continue; } r -= I_IN;
            if (r < I_QUP) { transpose_item(w_q_up, 384, 768, 24, WQUP, g_cq, false, scr, r, lane); continue; } r -= I_QUP;
            if (r < I_KVUP) { transpose_item(w_kv_up, 256, 1024, 32, WKVUP, g_ckv, false, scr, r, lane); continue; } r -= I_KVUP;
            if (r < I_OA) { transpose_item(w_o_a, 512, 1024, 32, WOA, nullptr, false, scr, r, lane); continue; } r -= I_OA;
            if (r < I_OA) { transpose_item(w_o_b, 512, 1024, 32, WOB, nullptr, false, scr, r, lane); continue; } r -= I_OA;
            if (r < I_OUT) { transpose_item(w_out, 1024, 1024, 32, WOUT, nullptr, false, scr, r, lane); continue; } r -= I_OUT;
            if (r < I_FF1) { transpose_item(w_ff1, 1024, 4096, 128, WFF1, g_mlp, false, scr, r, lane); continue; } r -= I_FF1;
            transpose_item(w_ff2, 4096, 1024, 32, WFF2, nullptr, false, scr, r, lane);
        }
        f32x4 gm[4];
#pragma unroll
        for (int j = 0; j < 4; ++j) gm[j] = *((const f32x4*)g_mix + lane + 64 * j);
        for (int m = gw; m < M; m += NGW) {
            const f32x4* xr = (const f32x4*)(x + (size_t)m * DM) + lane; f32x4 v[4]; float s = 0.f;
#pragma unroll
            for (int j = 0; j < 4; ++j) { v[j] = xr[64 * j]; s += (v[j][0] * v[j][0] + v[j][1] * v[j][1]) + (v[j][2] * v[j][2] + v[j][3] * v[j][3]); }
            const float rs = rsqrtf(wave_sum(s) * (1.f / DM) + EPS);
#pragma unroll
            for (int j = 0; j < 4; ++j) st4(XN + (size_t)m * DM + 4 * (lane + 64 * j), v[j] * rs * gm[j]);
        }
    }
    GRID_SYNC();
#if defined(DBG_STOP)
    if (DBG_STOP == 0) { int tid_ = threadIdx.x; asm volatile("" : "+v"(tid_)); const size_t gt = (size_t)bx * NTHREADS + tid_, NGT = (size_t)G * NTHREADS;
        const bf16_t* s0_ = (DBG_STOP == 0) ? XN : (DBG_STOP == 1) ? QA : (DBG_STOP == 2) ? QB : (DBG_STOP == 3) ? OA : Z;
        const bf16_t* s1_ = (DBG_STOP == 0) ? XN : (DBG_STOP == 1) ? CQ : (DBG_STOP == 2) ? VB : (DBG_STOP == 3) ? OB : Z;
        GRID_SYNC();
        for (size_t i = gt; i < (size_t)M * 512; i += NGT) { out[i] = bf2f(s0_[i]); out[(size_t)M * 512 + i] = bf2f(s1_[i]); }
        return; }
#endif
    { pg8::Gemm g{XN, WIN, M, NIN, 1024}; pg8::StaticOrder S; S.init(M, NIN, G, bx);
      EpiProj E{QA, KA, VA, CQ, CKV, KB, GT, ROWSS_Q, ROWSS_KV, KMEAN, ROPE64, ROPE32, b_gate};
      pg8::gemm_phase<EpiProj, pg8::StaticOrder, true, true>(lds, g, S, E); }
    GRID_SYNC();
#if defined(DBG_STOP)
    if (DBG_STOP == 1) { int tid_ = threadIdx.x; asm volatile("" : "+v"(tid_)); const size_t gt = (size_t)bx * NTHREADS + tid_, NGT = (size_t)G * NTHREADS;
        const bf16_t* s0_ = (DBG_STOP == 0) ? XN : (DBG_STOP == 1) ? QA : (DBG_STOP == 2) ? QB : (DBG_STOP == 3) ? OA : Z;
        const bf16_t* s1_ = (DBG_STOP == 0) ? XN : (DBG_STOP == 1) ? CQ : (DBG_STOP == 2) ? VB : (DBG_STOP == 3) ? OB : Z;
        GRID_SYNC();
        for (size_t i = gt; i < (size_t)M * 512; i += NGT) { out[i] = bf2f(s0_[i]); out[(size_t)M * 512 + i] = bf2f(s1_[i]); }
        return; }
#endif
    { pg8::Gemm g{CQ, WQUP, M, 768, 384}; pg8::StaticOrder S; S.init(M, 768, G, bx); EpiQup E{QB, ROWSS_Q, ROPE32};
      pg8::gemm_phase<EpiQup, pg8::StaticOrder, true, true>(lds, g, S, E); }
    __syncthreads();
    { pg8::Gemm g{CKV, WKVUP, M, 1024, 256}; pg8::StaticOrder S; S.init(M, 1024, G, bx); EpiKVup E{KB, VB, ROWSS_KV};
      pg8::gemm_phase<EpiKVup, pg8::StaticOrder, true, true>(lds, g, S, E); }
    GRID_SYNC();
#if defined(DBG_STOP)
    if (DBG_STOP == 2) { int tid_ = threadIdx.x; asm volatile("" : "+v"(tid_)); const size_t gt = (size_t)bx * NTHREADS + tid_, NGT = (size_t)G * NTHREADS;
        const bf16_t* s0_ = (DBG_STOP == 0) ? XN : (DBG_STOP == 1) ? QA : (DBG_STOP == 2) ? QB : (DBG_STOP == 3) ? OA : Z;
        const bf16_t* s1_ = (DBG_STOP == 0) ? XN : (DBG_STOP == 1) ? CQ : (DBG_STOP == 2) ? VB : (DBG_STOP == 3) ? OB : Z;
        GRID_SYNC();
        for (size_t i = gt; i < (size_t)M * 512; i += NGT) { out[i] = bf2f(s0_[i]); out[(size_t)M * 512 + i] = bf2f(s1_[i]); }
        return; }
#endif
#if defined(PROBE_REP)
    for (int rep_ = 0; rep_ < 2; ++rep_)
#endif
    for (int p = vcu; p < 512; p += G) {
#if defined(PROBE_REP)
        if (rep_ == 1 && (p >> 8) != PROBE_REP) continue;
#endif
        const int kind = p >> 8, bh = (p & 255) >> 4, s = p & 15, b = bh >> 3, h = bh & 7;
        if (kind == 0) { attn_unit<96, false>(b, h, 31 - s, QB, KB, VB, OB, nullptr, lds); attn_unit<96, false>(b, h, s, QB, KB, VB, OB, nullptr, lds); }
        else           { attn_unit<64, true>(b, h, 31 - s, QA, KA, VA, OA, KMEAN, lds); attn_unit<64, true>(b, h, s, QA, KA, VA, OA, KMEAN, lds); }
    }
    GRID_SYNC();
#if defined(DBG_STOP)
    if (DBG_STOP == 3) { int tid_ = threadIdx.x; asm volatile("" : "+v"(tid_)); const size_t gt = (size_t)bx * NTHREADS + tid_, NGT = (size_t)G * NTHREADS;
        const bf16_t* s0_ = (DBG_STOP == 0) ? XN : (DBG_STOP == 1) ? QA : (DBG_STOP == 2) ? QB : (DBG_STOP == 3) ? OA : Z;
        const bf16_t* s1_ = (DBG_STOP == 0) ? XN : (DBG_STOP == 1) ? CQ : (DBG_STOP == 2) ? VB : (DBG_STOP == 3) ? OB : Z;
        GRID_SYNC();
        for (size_t i = gt; i < (size_t)M * 512; i += NGT) { out[i] = bf2f(s0_[i]); out[(size_t)M * 512 + i] = bf2f(s1_[i]); }
        return; }
#endif
    { pg8::Gemm g{OA, WOA, M, 1024, 512}; pg8::StaticOrder S; S.init(M, 1024, G, bx); EpiGate<false> E{Z, GT};
      pg8::gemm_phase<EpiGate<false>, pg8::StaticOrder, true, true>(lds, g, S, E); }
    __syncthreads();
    { pg8::Gemm g{OB, WOB, M, 1024, 512}; pg8::StaticOrder S; S.init(M, 1024, G, bx); EpiGate<true> E{Z, GT + (size_t)M * 1024};
      pg8::gemm_phase<EpiGate<true>, pg8::StaticOrder, true, true>(lds, g, S, E); }
    GRID_SYNC();
#if defined(DBG_STOP)
    if (DBG_STOP == 4) { int tid_ = threadIdx.x; asm volatile("" : "+v"(tid_)); const size_t gt = (size_t)bx * NTHREADS + tid_, NGT = (size_t)G * NTHREADS;
        const bf16_t* s0_ = (DBG_STOP == 0) ? XN : (DBG_STOP == 1) ? QA : (DBG_STOP == 2) ? QB : (DBG_STOP == 3) ? OA : Z;
        const bf16_t* s1_ = (DBG_STOP == 0) ? XN : (DBG_STOP == 1) ? CQ : (DBG_STOP == 2) ? VB : (DBG_STOP == 3) ? OB : Z;
        GRID_SYNC();
        for (size_t i = gt; i < (size_t)M * 512; i += NGT) { out[i] = bf2f(s0_[i]); out[(size_t)M * 512 + i] = bf2f(s1_[i]); }
        return; }
#endif
    { pg8::Gemm g{Z, WOUT, M, 1024, 1024}; pg8::StaticOrder S; S.init(M, 1024, G, bx); EpiOut E{x, out, X1B, ROWSS2};
      pg8::gemm_phase<EpiOut, pg8::StaticOrder, true, true>(lds, g, S, E); }
    GRID_SYNC();
#if defined(PROBE_P6)
    for (int rep_ = 0; rep_ < 2; ++rep_)
#endif
    { pg8::Gemm g{X1B, WFF1, M, FF, 1024}; pg8::StaticOrder S; S.init(M, FF, G, bx); EpiFF1 E{U, ROWSS2};
      pg8::gemm_phase<EpiFF1, pg8::StaticOrder, true, true>(lds, g, S, E); __syncthreads(); }
    GRID_SYNC();
    { pg8::Gemm g{U, WFF2, M, 1024, FF}; pg8::StaticOrder S; S.init(M, 1024, G, bx); EpiFF2 E{out};
      pg8::gemm_phase<EpiFF2, pg8::StaticOrder, true, true>(lds, g, S, E); }
    GRID_SYNC();
    {
        int tid_ = threadIdx.x; asm volatile("" : "+v"(tid_)); const int tid = tid_, lane = tid & 63, wave = __builtin_amdgcn_readfirstlane(tid >> 6);
        const int gw = vcu * 8 + wave, NGW = G * 8;
        f32x4 gf[4];
#pragma unroll
        for (int j = 0; j < 4; ++j) gf[j] = *((const f32x4*)g_final + lane + 64 * j);
        for (int m = gw; m < M; m += NGW) {
            f32x4* xr = (f32x4*)(out + (size_t)m * DM) + lane; f32x4 v[4]; float s = 0.f;
#pragma unroll
            for (int j = 0; j < 4; ++j) { v[j] = xr[64 * j]; s += (v[j][0] * v[j][0] + v[j][1] * v[j][1]) + (v[j][2] * v[j][2] + v[j][3] * v[j][3]); }
            const float rs = rsqrtf(wave_sum(s) * (1.f / DM) + EPS);
#pragma unroll
            for (int j = 0; j < 4; ++j) xr[64 * j] = v[j] * rs * gf[j];
        }
    }
}

extern "C" void kernel_launch(void* const* d_in, const int* in_sizes, int n_in, void* d_out, int out_size, void* d_ws, size_t ws_size, hipStream_t stream) {
    static int grid = 0;
    if (grid == 0) {
        if (n_in != 15 || out_size != M * DM || ws_size < WS_END) { fprintf(stderr, "kernel_launch: unexpected shapes (n_in %d out %d ws %zu)\n", n_in, out_size, ws_size); grid = -1; return; }
        int dev = 0, cus = 0, per_cu = 0;
        hipGetDevice(&dev); hipDeviceGetAttribute(&cus, hipDeviceAttributeMultiprocessorCount, dev);
        if (hipFuncSetAttribute((const void*)fwd_megakernel, hipFuncAttributeMaxDynamicSharedMemorySize, LDS_BYTES) != hipSuccess) { fprintf(stderr, "kernel_launch: hipFuncSetAttribute failed\n"); grid = -1; return; }
        if (hipOccupancyMaxActiveBlocksPerMultiprocessor(&per_cu, (const void*)fwd_megakernel, NTHREADS, LDS_BYTES) != hipSuccess || per_cu < 1) { fprintf(stderr, "kernel_launch: occupancy query gave %d\n", per_cu); per_cu = 1; }
        (void)hipGetLastError();
        grid = cus * per_cu;
    }
    if (grid < 0) return;
    if (hipMemsetAsync((char*)d_ws + WS_BAR, 0, WS_BAR_BYTES, stream) != hipSuccess) { fprintf(stderr, "kernel_launch: memset failed\n"); return; }
    Args a{};
    for (int i = 0; i < 15; ++i) a.in[i] = (const float*)d_in[i];
    a.out = (float*)d_out; a.ws = (unsigned char*)d_ws;
    void* args[] = {&a};
    hipError_t e = hipLaunchCooperativeKernel((const void*)fwd_megakernel, dim3(grid), dim3(NTHREADS), args, LDS_BYTES, stream);
    if (e != hipSuccess) fprintf(stderr, "cooperative launch failed: %s (grid %d)\n", hipGetErrorString(e), grid);
}
```

```cpp
#include <hip/hip_runtime.h>
#include <hip/hip_cooperative_groups.h>
#include <cstdio>
#include <cstdint>
namespace cg = cooperative_groups;
namespace pg8 {
#define PG8_LAS __attribute__((address_space(3)))
typedef unsigned short bf16_t;
typedef short bf16x8 __attribute__((ext_vector_type(8)));
typedef float f32x4 __attribute__((ext_vector_type(4)));
typedef unsigned u32x4 __attribute__((ext_vector_type(4)));
constexpr int BM = 256, BK = 64, HALF = 128, HTB = HALF * BK * 2  , STAGE_BYTES = 8 * HTB, NXCD = 8, WGM = 8;

__host__ __device__ __forceinline__ int lds_byte(int r, int c) { const int st = (r >> 4) * 2 + (c >> 5), rr = r & 15, cc = c & 31, ob = rr * 64 + cc * 2; return st * 1024 + (ob ^ (((ob >> 9) & 1) << 5)); }
__host__ __device__ __forceinline__ void stage_rc(int b, int& R, int& C) { const int st = b / 1024, sb = b % 1024, swz = sb ^ (((sb >> 9) & 1) << 5); R = (st >> 1) * 16 + swz / 64; C = (st & 1) * 32 + (swz % 64) / 2; }
__host__ __device__ __forceinline__ int perm32(int rho) { const int n = rho >> 4, i = rho & 15; return 8 * (i >> 2) + 4 * n + (i & 3); }

struct Unit { int pm, pn; };
struct Gemm { const bf16_t* A; const bf16_t* Bt; int M, N, K; };

struct StaticOrder {
    int nM, nN, nwg, G, c;
    __host__ __device__ void init(int M, int N, int G_, int c_) { nM = M / BM; nN = N / BM; nwg = nM * nN; G = G_; c = c_; }
    __host__ __device__ bool next(int i, Unit& u) const {
        const long L = (long)i * G + c; if (L >= nwg) return false;
        int wgid = (int)L; { const int q = nwg / NXCD, r = nwg % NXCD, xcd = wgid % NXCD, off = wgid / NXCD; wgid = (xcd < r ? xcd * (q + 1) : r * (q + 1) + (xcd - r) * q) + off; }
        const int nig = WGM * nN, gid = wgid / nig, fm = gid * WGM, gsz = (nM - fm) < WGM ? (nM - fm) : WGM;
        u.pm = fm + ((wgid % nig) % gsz); u.pn = (wgid % nig) / gsz; return true;
    }
    __device__ __forceinline__ void a_ready(const Unit&) const {}
    __device__ __forceinline__ void done(const Unit&) const {}
};

__device__ __forceinline__ unsigned cvt_pk_bf16(float lo, float hi) { unsigned r; asm volatile("v_cvt_pk_bf16_f32 %0, %1, %2" : "=v"(r) : "v"(lo), "v"(hi)); return r; }
typedef float f32x2 __attribute__((ext_vector_type(2)));
template <class Epi, class Sched, bool ALIGN_EPI = false, bool SP2 = false>
__device__ __forceinline__ void gemm_phase(PG8_LAS unsigned char* lds, const Gemm g, const Sched& S, const Epi& E) {
    int tid_ = threadIdx.x; asm volatile("" : "+v"(tid_));
    const int tid = tid_, wid = __builtin_amdgcn_readfirstlane(tid >> 6), lane = tid & 63, wr = wid >> 2, wc = wid & 3, fr = lane & 15, fq = lane >> 4;
    const int K = g.K, nt = K / BK;
    unsigned voffA[2], voffB[2];
#pragma unroll
    for (int i = 0; i < 2; ++i) { int R, C; stage_rc(tid * 16 + i * 8192, R, C); const int Rb = Epi::PERM ? ((R & ~31) + perm32(R & 31)) : R;
        voffA[i] = (unsigned)(R * K + C) * 2u; voffB[i] = (unsigned)(Rb * K + C) * 2u; }
    const size_t kstep = (size_t)(BK * 2);
    const size_t hstep = (size_t)HALF * K * 2;
    const size_t tstep = 2 * hstep;
    const unsigned ldsw = (unsigned)wid * 1024u;
    const int aoff = lds_byte(wr * 64 + fr, fq * 8), boff = lds_byte(wc * 32 + fr, fq * 8);
#define PG8_SA(b, h) (((b) * 2 + (h)) * HTB)
#define PG8_SB(b, h) ((4 + (b) * 2 + (h)) * HTB)
#define PG8_STAGE(bufoff, gbase, voff) do { _Pragma("unroll") for (int _i = 0; _i < 2; ++_i) \
        __builtin_amdgcn_global_load_lds((const unsigned*)((const char*)(gbase) + (voff)[_i]), (PG8_LAS unsigned*)(lds + (bufoff) + ldsw + _i * 8192), 16, 0, 0); } while (0)
#define PG8_LDA(dst, b, h) do { _Pragma("unroll") for (int m = 0; m < 4; ++m) _Pragma("unroll") for (int k = 0; k < 2; ++k) dst[m][k] = *(const PG8_LAS bf16x8*)(lds + PG8_SA(b, h) + aoff + m * 2048 + k * 1024); } while (0)
#define PG8_LDB(dst, b, h) do { _Pragma("unroll") for (int n = 0; n < 2; ++n) _Pragma("unroll") for (int k = 0; k < 2; ++k) dst[n][k] = *(const PG8_LAS bf16x8*)(lds + PG8_SB(b, h) + boff + n * 2048 + k * 1024); } while (0)
#define PG8_MMA(ai, bj, At, Bt) do { __builtin_amdgcn_s_setprio(1); _Pragma("unroll") for (int m = 0; m < 4; ++m) _Pragma("unroll") for (int n = 0; n < 2; ++n) _Pragma("unroll") for (int k = 0; k < 2; ++k) \
        acc[ai][bj][m][n] = __builtin_amdgcn_mfma_f32_16x16x32_bf16(Bt[n][k], At[m][k], acc[ai][bj][m][n], 0, 0, 0); __builtin_amdgcn_s_setprio(0); } while (0)
#define PG8_WAIT_V(n) asm volatile("s_waitcnt vmcnt(" #n ")" ::: "memory")
#define PG8_WAIT_L(n) asm volatile("s_waitcnt lgkmcnt(" #n ")" ::: "memory")
#define PG8_BAR __builtin_amdgcn_s_barrier()
#define PG8_SCHED __builtin_amdgcn_sched_barrier(0)
    Unit cur, nxt; int ui = 0;
    if (!S.next(0, cur)) return;
    f32x4 acc[2][2][4][2];
#pragma unroll
    for (int a = 0; a < 2; ++a)
#pragma unroll
        for (int b = 0; b < 2; ++b)
#pragma unroll
            for (int m = 0; m < 4; ++m)
#pragma unroll
                for (int n = 0; n < 2; ++n) acc[a][b][m][n] = (f32x4){0.f, 0.f, 0.f, 0.f};
    bf16x8 At[4][2], B0[2][2], B1[2][2];
    const char* cA = (const char*)g.A + (size_t)cur.pm * tstep; const char* cB = (const char*)g.Bt + (size_t)cur.pn * tstep;
    S.a_ready(cur);
    if constexpr (SP2) {
        PG8_STAGE(PG8_SB(0, 0), cB, voffB); PG8_STAGE(PG8_SB(0, 1), cB + hstep, voffB); PG8_STAGE(PG8_SA(0, 0), cA, voffA); PG8_STAGE(PG8_SA(0, 1), cA + hstep, voffA);
        if (wr == 1) PG8_BAR;
        PG8_WAIT_V(2); PG8_BAR;
        PG8_STAGE(PG8_SB(1, 0), cB + kstep, voffB); PG8_STAGE(PG8_SA(1, 0), cA + kstep, voffA); PG8_STAGE(PG8_SB(1, 1), cB + hstep + kstep, voffB);
        PG8_WAIT_V(6); PG8_BAR;
    } else {
        PG8_STAGE(PG8_SB(0, 0), cB, voffB); PG8_STAGE(PG8_SA(0, 0), cA, voffA); PG8_STAGE(PG8_SB(0, 1), cB + hstep, voffB); PG8_STAGE(PG8_SA(0, 1), cA + hstep, voffA);
        if (wr == 1) PG8_BAR;
        PG8_WAIT_V(4); PG8_BAR;
        PG8_STAGE(PG8_SB(1, 0), cB + kstep, voffB); PG8_STAGE(PG8_SA(1, 0), cA + kstep, voffA); PG8_STAGE(PG8_SB(1, 1), cB + hstep + kstep, voffB);
        PG8_WAIT_V(6); PG8_BAR;
    }
    for (;;) {
        const bool has_next = S.next(ui + 1, nxt);
        const char* nA = has_next ? (const char*)g.A + (size_t)nxt.pm * tstep : cA; const char* nB = has_next ? (const char*)g.Bt + (size_t)nxt.pn * tstep : cB;
        for (int t = 0; t < nt; t += 2) {
            const bool last = (t == nt - 2);
            const char* a1 = cA + (size_t)(t + 1) * kstep;
            const char* a2 = last ? nA : cA + (size_t)(t + 2) * kstep; const char* b2 = last ? nB : cB + (size_t)(t + 2) * kstep;
            const char* a3 = a2 + kstep; const char* b3 = b2 + kstep;
            if (last && has_next) S.a_ready(nxt);
            if constexpr (SP2) {
            PG8_LDB(B0, 0, 0); PG8_LDB(B1, 0, 1); PG8_SCHED; PG8_LDA(At, 0, 0); PG8_STAGE(PG8_SA(1, 1), a1 + hstep, voffA);
            PG8_WAIT_V(8); PG8_WAIT_L(0); PG8_BAR; PG8_MMA(0, 0, At, B0); PG8_MMA(0, 1, At, B1); PG8_BAR; PG8_SCHED;
            PG8_LDA(At, 0, 1); PG8_STAGE(PG8_SB(0, 0), b2, voffB); PG8_STAGE(PG8_SB(0, 1), b2 + hstep, voffB); PG8_STAGE(PG8_SA(0, 0), a2, voffA);
            PG8_WAIT_V(8); PG8_WAIT_L(0); PG8_BAR; PG8_MMA(1, 0, At, B0); PG8_MMA(1, 1, At, B1); PG8_BAR; PG8_SCHED;
            PG8_LDB(B0, 1, 0); PG8_LDB(B1, 1, 1); PG8_SCHED; PG8_LDA(At, 1, 0); PG8_STAGE(PG8_SA(0, 1), a2 + hstep, voffA);
            PG8_WAIT_V(8); PG8_WAIT_L(0); PG8_BAR; PG8_MMA(0, 0, At, B0); PG8_MMA(0, 1, At, B1); PG8_BAR; PG8_SCHED;
            PG8_LDA(At, 1, 1); PG8_STAGE(PG8_SB(1, 0), b3, voffB); PG8_STAGE(PG8_SB(1, 1), b3 + hstep, voffB); PG8_STAGE(PG8_SA(1, 0), a3, voffA);
            PG8_WAIT_V(8); PG8_WAIT_L(0); PG8_BAR; PG8_MMA(1, 0, At, B0); PG8_MMA(1, 1, At, B1); PG8_BAR; PG8_SCHED;
            } else {
            PG8_LDB(B0, 0, 0); PG8_SCHED; PG8_LDA(At, 0, 0); PG8_STAGE(PG8_SA(1, 1), a1 + hstep, voffA);
            PG8_WAIT_L(8); PG8_BAR; PG8_WAIT_L(0); PG8_MMA(0, 0, At, B0); PG8_BAR; PG8_SCHED;
            PG8_LDB(B1, 0, 1); PG8_STAGE(PG8_SB(0, 0), b2, voffB);
            PG8_BAR; PG8_WAIT_L(0); PG8_MMA(0, 1, At, B1); PG8_BAR;
            PG8_LDA(At, 0, 1); PG8_STAGE(PG8_SA(0, 0), a2, voffA);
            PG8_BAR; PG8_WAIT_L(0); PG8_MMA(1, 0, At, B0); PG8_BAR; PG8_SCHED;
            PG8_STAGE(PG8_SB(0, 1), b2 + hstep, voffB);
            PG8_WAIT_V(6); PG8_BAR; PG8_MMA(1, 1, At, B1); PG8_BAR;
            PG8_LDB(B0, 1, 0); PG8_SCHED; PG8_LDA(At, 1, 0); PG8_STAGE(PG8_SA(0, 1), a2 + hstep, voffA);
            PG8_WAIT_L(8); PG8_BAR; PG8_WAIT_L(0); PG8_MMA(0, 0, At, B0); PG8_BAR; PG8_SCHED;
            PG8_LDB(B1, 1, 1); PG8_STAGE(PG8_SB(1, 0), b3, voffB);
            PG8_BAR; PG8_WAIT_L(0); PG8_MMA(0, 1, At, B1); PG8_BAR;
            PG8_LDA(At, 1, 1); PG8_STAGE(PG8_SA(1, 0), a3, voffA);
            PG8_BAR; PG8_WAIT_L(0); PG8_MMA(1, 0, At, B0); PG8_BAR; PG8_SCHED;
            PG8_STAGE(PG8_SB(1, 1), b3 + hstep, voffB);
            PG8_WAIT_V(6); PG8_BAR; PG8_MMA(1, 1, At, B1); PG8_BAR;
            }
        }
        if constexpr (ALIGN_EPI) { if (wr == 0) PG8_BAR; }
        if constexpr (!Epi::AFTER_DRAIN) { E(acc, cur, wr, wc, fr, fq); S.done(cur); }
        if (!has_next) break;
#pragma unroll
        for (int a = 0; a < 2; ++a)
#pragma unroll
            for (int b = 0; b < 2; ++b)
#pragma unroll
                for (int m = 0; m < 4; ++m)
#pragma unroll
                    for (int n = 0; n < 2; ++n) acc[a][b][m][n] = (f32x4){0.f, 0.f, 0.f, 0.f};
        cur = nxt; cA = nA; cB = nB; ++ui;
        if constexpr (ALIGN_EPI) { if (wr == 1) PG8_BAR; }
    }
    PG8_WAIT_V(0);
    if constexpr (!ALIGN_EPI) { if (wr == 0) PG8_BAR; }
    PG8_BAR;
    if constexpr (Epi::AFTER_DRAIN) { E.fused(acc, cur, wr, wc, fr, fq, lds, wid, lane); S.done(cur); }
#undef PG8_SA
#undef PG8_SB
#undef PG8_STAGE
#undef PG8_LDA
#undef PG8_LDB
#undef PG8_MMA
#undef PG8_WAIT_V
#undef PG8_WAIT_L
#undef PG8_BAR
#undef PG8_SCHED
}
}

#define LAS __attribute__((address_space(3)))
typedef unsigned short bf16_t;
typedef short bf16x8 __attribute__((ext_vector_type(8)));
typedef float f32x4 __attribute__((ext_vector_type(4)));
typedef float f32x16 __attribute__((ext_vector_type(16)));
typedef unsigned u32x2 __attribute__((ext_vector_type(2)));
typedef unsigned u32x4 __attribute__((ext_vector_type(4)));

#define XB_TMO      128
#define XB_XCNT(j)  (256  + 64 * (j))
#define XB_XSUB(j)  (1280 + 64 * (j))
#define XB_XGEN(j)  (2304 + 64 * (j))
#define XB_TOP      3328
#define XB_TOPGEN   3392
#define XCD_BAR_WORDS 3456
#define XB_SPIN_CAP (1u << 18)

__device__ __forceinline__ unsigned xb_ld(unsigned* p)              { return __hip_atomic_load(p, __ATOMIC_RELAXED, __HIP_MEMORY_SCOPE_AGENT); }
__device__ __forceinline__ unsigned xb_add(unsigned* p, unsigned v) { return __hip_atomic_fetch_add(p, v, __ATOMIC_RELAXED, __HIP_MEMORY_SCOPE_AGENT); }
__device__ __forceinline__ unsigned xb_xcc_id() { return (unsigned)__builtin_amdgcn_s_getreg((3 << 11) | 20) & 0xFu; }
#define XB_SPIN(cond, bar) do { unsigned _sp = 0; while (cond) { __builtin_amdgcn_s_sleep(1); \
    if ((++_sp & 255u) == 0u) { if (xb_ld(&(bar)[XB_TMO])) break; if (_sp > XB_SPIN_CAP) { atomicAdd(&(bar)[XB_TMO], 1u); break; } } } } while (0)

struct XcdBarrier {
    unsigned* bar; unsigned x;
    volatile LAS unsigned* st;
};

__device__ __forceinline__ XcdBarrier xcd_barrier_post(unsigned* bar, volatile LAS unsigned* st) {
    XcdBarrier b; b.bar = bar; b.x = xb_xcc_id(); b.st = st;
    if (threadIdx.x == 0) (void)xb_add(&bar[XB_XCNT(b.x)], 1u);
    return b;
}
__device__ __forceinline__ void xcd_barrier_complete(unsigned* bar, unsigned x, unsigned& nloc, unsigned& nx) {
    const unsigned G = gridDim.x * gridDim.y * gridDim.z;
    unsigned sum, cnt, mine, sp = 0u;
    for (;;) {
        sum = 0u; cnt = 0u; mine = 0u;
#pragma unroll
        for (unsigned j = 0; j < 16; ++j) { const unsigned c = xb_ld(&bar[XB_XCNT(j)]); sum += c; cnt += (c > 0u) ? 1u : 0u; mine = (j == x) ? c : mine; }
        if (sum == G) break;
        __builtin_amdgcn_s_sleep(1);
        if ((++sp & 255u) == 0u) { if (xb_ld(&bar[XB_TMO])) break; if (sp > XB_SPIN_CAP) { atomicAdd(&bar[XB_TMO], 1u); break; } }
    }
    nloc = mine > 0u ? mine : 1u; nx = cnt > 0u ? cnt : 1u;
}

__device__ __forceinline__ void xcd_barrier(const XcdBarrier& b) {
    asm volatile("s_waitcnt vmcnt(0)" ::: "memory");
    __syncthreads();
    if (threadIdx.x == 0) {
        unsigned* bar = b.bar;
        __builtin_amdgcn_s_waitcnt(0);
        unsigned nloc = b.st[0], nx = b.st[1];
        if (nloc == 0u) { xcd_barrier_complete(bar, b.x, nloc, nx); b.st[0] = nloc; b.st[1] = nx; }
        const unsigned old = xb_add(&bar[XB_XSUB(b.x)], 1u);
        const unsigned gen = old / nloc;
        if (old + 1u == (gen + 1u) * nloc) {
            __builtin_amdgcn_fence(__ATOMIC_RELEASE, "agent");
            asm volatile("s_waitcnt vmcnt(0)" ::: "memory");
            const unsigned og = xb_add(&bar[XB_TOP], 1u);
            const unsigned tg = og / nx;
            if (og + 1u == (tg + 1u) * nx) xb_add(&bar[XB_TOPGEN], 1u);
            else XB_SPIN(xb_ld(&bar[XB_TOPGEN]) == tg, bar);
            __builtin_amdgcn_fence(__ATOMIC_ACQUIRE, "agent");
            xb_add(&bar[XB_XGEN(b.x)], 1u);
            asm volatile("s_waitcnt vmcnt(0)" ::: "memory");
        } else {
            XB_SPIN(xb_ld(&bar[XB_XGEN(b.x)]) == gen, bar);
            __builtin_amdgcn_fence(__ATOMIC_ACQUIRE, "agent");
            asm volatile("s_waitcnt vmcnt(0)" ::: "memory");
        }
    }
    __syncthreads();
}

constexpr int SEQ = 8192, NBATCH = 2, M = NBATCH * SEQ, DM = 1024, FF = 4096;
constexpr int NIN = 4352;
constexpr float EPS = 1e-6f;
constexpr float LOG2E = 1.4426950408889634f;
constexpr float C_A = 0.125f * LOG2E;
constexpr float C_B = 0.10206207261596575f * LOG2E;
constexpr size_t MiB = 1u << 20;
constexpr size_t WS_BAR = 512 * 1024, WS_BAR_BYTES = 16384;
constexpr size_t WS_ROWSS_Q = 0, WS_ROWSS_KV = 65536, WS_ROWSS2 = 131072, WS_KMEAN = 196608, WS_CNT = 327680, WS_CTL_END = 329728;
constexpr size_t WS_PART_ML = 116 * MiB  , WS_PART_O = 204 * MiB, WS_LIST = 252 * MiB;
constexpr size_t WS_WIN = 1 * MiB, WS_WQUP = 10 * MiB, WS_WKVUP = 11 * MiB, WS_WOA = 12 * MiB, WS_WOB = 13 * MiB, WS_WOUT = 14 * MiB, WS_WFF1 = 16 * MiB, WS_WFF2 = 24 * MiB;
constexpr size_t WS_ROPE64 = 32 * MiB, WS_ROPE32 = 34 * MiB;
constexpr size_t WS_XN = 36 * MiB, WS_OA = 36 * MiB, WS_OB = 52 * MiB, WS_X1B = 36 * MiB;
constexpr size_t WS_QA = 68 * MiB, WS_KA = 84 * MiB, WS_VA = 100 * MiB, WS_CQ = 116 * MiB, WS_CKV = 128 * MiB, WS_QB = 138 * MiB, WS_KB = 162 * MiB, WS_VB = 186 * MiB;
constexpr size_t WS_Z = 68 * MiB, WS_U = 68 * MiB, WS_END = 256 * MiB;
constexpr int LDS_BYTES = 147456;
constexpr int NTHREADS = 512;

typedef float f32x2_t __attribute__((ext_vector_type(2))); typedef __bf16 bf16x2_t __attribute__((ext_vector_type(2)));
__device__ __forceinline__ unsigned cvtpk(float lo, float hi) { f32x2_t v = {lo, hi}; bf16x2_t b = __builtin_convertvector(v, bf16x2_t); return __builtin_bit_cast(unsigned, b); }
__device__ __forceinline__ void st4(bf16_t* p, f32x4 v) { u32x2 w; w.x = cvtpk(v[0], v[1]); w.y = cvtpk(v[2], v[3]); *(u32x2*)p = w; }
__device__ __forceinline__ float bf2f(unsigned short s) { return __uint_as_float(((unsigned)s) << 16); }
__device__ __forceinline__ f32x4 ld4bf(const bf16_t* p) { const u32x2 w = *(const u32x2*)p; return (f32x4){__uint_as_float(w.x << 16), __uint_as_float(w.x & 0xffff0000u), __uint_as_float(w.y << 16), __uint_as_float(w.y & 0xffff0000u)}; }
__device__ __forceinline__ float wave_sum(float v) {
#pragma unroll
    for (int o = 1; o < 64; o <<= 1) v += __shfl_xor(v, o);
    return v;
}

#define EPI_ROWS(ai, m) for (int ai = 0; ai < 2; ++ai) _Pragma("unroll") for (int m = 0; m < 4; ++m)

struct EpiProj {
    static constexpr bool PERM = false, AFTER_DRAIN = false;
    bf16_t *QA, *KA, *VA, *CQ, *CKV, *KB, *G; float *ROWSS_Q, *ROWSS_KV, *KMEAN; const float *ROPE64, *ROPE32, *b_gate;
    __device__ __forceinline__ void operator()(const f32x4 (&acc)[2][2][4][2], const pg8::Unit& u, int wr, int wc, int fr, int fq) const {
        const int pn = u.pn; const int row0 = u.pm * 256 + wr * 64 + fr; const int cl = wc * 32 + 4 * fq;
        if (pn < 4) {
            bf16_t* dst = pn < 2 ? QA : KA; const int cbase = (pn & 1) * 256; const float sc = pn < 2 ? C_A : 1.f; const int fi = 16 * (wc & 1) + 4 * fq;
            f32x4 ks[2][2];
#pragma unroll
            for (int bj = 0; bj < 2; ++bj) { ks[bj][0] = (f32x4){0.f, 0.f, 0.f, 0.f}; ks[bj][1] = (f32x4){0.f, 0.f, 0.f, 0.f}; }
#pragma unroll
            EPI_ROWS(ai, m) {
                const int row = row0 + 128 * ai + 16 * m; const int pos = row & (SEQ - 1);
                const f32x4* rp = (const f32x4*)(ROPE64 + ((size_t)pos * 32 + fi) * 2); const f32x4 r01 = rp[0], r23 = rp[1];
                const f32x4 c = (f32x4){r01[0], r01[2], r23[0], r23[2]}, s = (f32x4){r01[1], r01[3], r23[1], r23[3]};
#pragma unroll
                for (int bj = 0; bj < 2; ++bj) {
                    const f32x4 x1 = acc[ai][bj][m][0], x2 = acc[ai][bj][m][1];
                    const f32x4 o1 = x1 * c - x2 * s, o2 = x2 * c + x1 * s;
                    ks[bj][0] += o1; ks[bj][1] += o2;
                    bf16_t* p = dst + (size_t)row * 512 + cbase + 128 * bj + cl;
                    st4(p, o1 * sc); st4(p + 16, o2 * sc);
                }
            }
            if (pn >= 2) {
#pragma unroll
                for (int bj = 0; bj < 2; ++bj)
#pragma unroll
                    for (int n = 0; n < 2; ++n)
#pragma unroll
                        for (int j = 0; j < 4; ++j) { float v = ks[bj][n][j]; v += __shfl_xor(v, 1); v += __shfl_xor(v, 2); v += __shfl_xor(v, 4); v += __shfl_xor(v, 8);
                            if (fr == 0) unsafeAtomicAdd(KMEAN + (size_t)u.pm * 512 + cbase + 128 * bj + cl + 16 * n + j, v * (1.f / 256.f)); }
            }
        } else if (pn < 6) {
            const int cbase = (pn - 4) * 256;
#pragma unroll
            EPI_ROWS(ai, m) { const int row = row0 + 128 * ai + 16 * m;
#pragma unroll
                for (int bj = 0; bj < 2; ++bj)
#pragma unroll
                    for (int n = 0; n < 2; ++n) st4(VA + (size_t)row * 512 + cbase + 128 * bj + cl + 16 * n, acc[ai][bj][m][n]); }
        } else if (pn < 9) {
#pragma unroll
            EPI_ROWS(ai, m) { const int row = row0 + 128 * ai + 16 * m; float sq = 0.f, skv = 0.f;
#pragma unroll
                for (int bj = 0; bj < 2; ++bj) {
                    const f32x4 v0 = acc[ai][bj][m][0], v1 = acc[ai][bj][m][1];
                    const float ss = (v0[0] * v0[0] + v0[1] * v0[1]) + (v0[2] * v0[2] + v0[3] * v0[3]) + (v1[0] * v1[0] + v1[1] * v1[1]) + (v1[2] * v1[2] + v1[3] * v1[3]);
                    const int sel = (pn - 6) * 2 + bj;
                    if (sel < 3) { sq += ss; bf16_t* p = CQ + (size_t)row * 384 + 128 * sel + cl; st4(p, v0); st4(p + 16, v1); }
                    else if (sel < 5) { skv += ss; bf16_t* p = CKV + (size_t)row * 256 + 128 * (sel - 3) + cl; st4(p, v0); st4(p + 16, v1); }
                    else if (wc == 0) {
                        const int pos = row & (SEQ - 1);
                        const f32x4* rp = (const f32x4*)(ROPE32 + ((size_t)pos * 16 + 4 * fq) * 2); const f32x4 r01 = rp[0], r23 = rp[1];
                        const f32x4 c = (f32x4){r01[0], r01[2], r23[0], r23[2]}, s = (f32x4){r01[1], r01[3], r23[1], r23[3]};
                        const f32x4 o1 = v0 * c - v1 * s, o2 = v1 * c + v0 * s;
#pragma unroll
                        for (int h = 0; h < 8; ++h) { bf16_t* p = KB + (size_t)row * 768 + 96 * h + 64 + 4 * fq; st4(p, o1); st4(p + 16, o2); }
                    }
                }
                if (pn < 8) { sq += __shfl_xor(sq, 16); sq += __shfl_xor(sq, 32); if (fq == 0) unsafeAtomicAdd(ROWSS_Q + row, sq); }
                if (pn > 6) { skv += __shfl_xor(skv, 16); skv += __shfl_xor(skv, 32); if (fq == 0) unsafeAtomicAdd(ROWSS_KV + row, skv); }
            }
        } else {
            const int gbase = (pn - 9) * 256;
#pragma unroll
            for (int bj = 0; bj < 2; ++bj)
#pragma unroll
                for (int n = 0; n < 2; ++n) {
                    const int gc = gbase + 128 * bj + cl + 16 * n; const f32x4 bv = *(const f32x4*)(b_gate + gc);
                    bf16_t* dst = G + (size_t)(gc >> 10) * ((size_t)M * 1024) + (gc & 1023);
#pragma unroll
                    EPI_ROWS(ai, m) { const int row = row0 + 128 * ai + 16 * m; f32x4 v = acc[ai][bj][m][n] + bv;
#pragma unroll
                        for (int j = 0; j < 4; ++j) v[j] = __builtin_amdgcn_rcpf(1.f + __builtin_amdgcn_exp2f(-LOG2E * v[j]));
                        st4(dst + (size_t)row * 1024, v); }
                }
        }
    }
};
struct EpiQup {
    static constexpr bool PERM = false, AFTER_DRAIN = false;
    bf16_t* QB; const float *ROWSS_Q, *ROPE32;
    __device__ __forceinline__ void operator()(const f32x4 (&acc)[2][2][4][2], const pg8::Unit& u, int wr, int wc, int fr, int fq) const {
        const int row0 = u.pm * 256 + wr * 64 + fr;
#pragma unroll
        EPI_ROWS(ai, m) { const int row = row0 + 128 * ai + 16 * m; const float rs = rsqrtf(ROWSS_Q[row] * (1.f / 384.f) + EPS) * C_B; const int pos = row & (SEQ - 1);
#pragma unroll
            for (int bj = 0; bj < 2; ++bj) {
                const int grp = 8 * u.pn + 4 * bj + wc; const int part = grp % 3;
                f32x4 v0 = acc[ai][bj][m][0] * rs, v1 = acc[ai][bj][m][1] * rs;
                if (part == 2) {
                    const f32x4* rp = (const f32x4*)(ROPE32 + ((size_t)pos * 16 + 4 * fq) * 2); const f32x4 r01 = rp[0], r23 = rp[1];
                    const f32x4 c = (f32x4){r01[0], r01[2], r23[0], r23[2]}, s = (f32x4){r01[1], r01[3], r23[1], r23[3]};
                    const f32x4 o1 = v0 * c - v1 * s, o2 = v1 * c + v0 * s; v0 = o1; v1 = o2;
                }
                bf16_t* p = QB + (size_t)row * 768 + 32 * grp + 4 * fq; st4(p, v0); st4(p + 16, v1);
            } }
    }
};
struct EpiKVup {
    static constexpr bool PERM = false, AFTER_DRAIN = false;
    bf16_t *KB, *VB; const float* ROWSS_KV;
    __device__ __forceinline__ void operator()(const f32x4 (&acc)[2][2][4][2], const pg8::Unit& u, int wr, int wc, int fr, int fq) const {
        const int row0 = u.pm * 256 + wr * 64 + fr;
#pragma unroll
        EPI_ROWS(ai, m) { const int row = row0 + 128 * ai + 16 * m; const float rs = rsqrtf(ROWSS_KV[row] * (1.f / 256.f) + EPS);
#pragma unroll
            for (int bj = 0; bj < 2; ++bj) { const int head = 2 * u.pn + bj;
                bf16_t* p = (wc < 2) ? KB + (size_t)row * 768 + 96 * head + 32 * wc + 4 * fq : VB + (size_t)row * 512 + 64 * head + 32 * (wc - 2) + 4 * fq;
                st4(p, acc[ai][bj][m][0] * rs); st4(p + 16, acc[ai][bj][m][1] * rs); } }
    }
};
template <bool ADD> struct EpiGate {
    static constexpr bool PERM = false, AFTER_DRAIN = false;
    bf16_t* Z; const bf16_t* Gt;
    __device__ __forceinline__ void operator()(const f32x4 (&acc)[2][2][4][2], const pg8::Unit& u, int wr, int wc, int fr, int fq) const {
        const int row0 = u.pm * 256 + wr * 64 + fr; const int col0 = u.pn * 256 + wc * 32 + 4 * fq;
#pragma unroll
        EPI_ROWS(ai, m) { const size_t ro = (size_t)(row0 + 128 * ai + 16 * m) * 1024 + col0;
#pragma unroll
            for (int bj = 0; bj < 2; ++bj)
#pragma unroll
                for (int n = 0; n < 2; ++n) { const size_t o = ro + 128 * bj + 16 * n; f32x4 v = acc[ai][bj][m][n] * ld4bf(Gt + o); if (ADD) v += ld4bf(Z + o); st4(Z + o, v); } }
    }
};
struct EpiOut {
    static constexpr bool PERM = false, AFTER_DRAIN = false;
    const float* X; float* X1; bf16_t* X1B; float* ROWSS2;
    __device__ __forceinline__ void operator()(const f32x4 (&acc)[2][2][4][2], const pg8::Unit& u, int wr, int wc, int fr, int fq) const {
        const int row0 = u.pm * 256 + wr * 64 + fr; const int col0 = u.pn * 256 + wc * 32 + 4 * fq;
#pragma unroll
        EPI_ROWS(ai, m) { const int row = row0 + 128 * ai + 16 * m; const size_t ro = (size_t)row * 1024 + col0; float ss = 0.f;
#pragma unroll
            for (int bj = 0; bj < 2; ++bj)
#pragma unroll
                for (int n = 0; n < 2; ++n) { const size_t o = ro + 128 * bj + 16 * n; const f32x4 v = acc[ai][bj][m][n] + *(const f32x4*)(X + o);
                    ss += (v[0] * v[0] + v[1] * v[1]) + (v[2] * v[2] + v[3] * v[3]); *(f32x4*)(X1 + o) = v; st4(X1B + o, v); }
            ss += __shfl_xor(ss, 16); ss += __shfl_xor(ss, 32); if (fq == 0) unsafeAtomicAdd(ROWSS2 + row, ss); }
    }
};
struct EpiFF1 {
    static constexpr bool PERM = false, AFTER_DRAIN = false;
    bf16_t* U; const float* ROWSS2;
    __device__ __forceinline__ void operator()(const f32x4 (&acc)[2][2][4][2], const pg8::Unit& u, int wr, int wc, int fr, int fq) const {
        const int row0 = u.pm * 256 + wr * 64 + fr; const int col0 = u.pn * 256 + wc * 32 + 4 * fq;
#pragma unroll
        EPI_ROWS(ai, m) { const int row = row0 + 128 * ai + 16 * m; const float r2 = 1.f / (ROWSS2[row] * (1.f / 1024.f) + EPS);
#pragma unroll
            for (int bj = 0; bj < 2; ++bj)
#pragma unroll
                for (int n = 0; n < 2; ++n) { f32x4 v = acc[ai][bj][m][n];
#pragma unroll
                    for (int j = 0; j < 4; ++j) { const float t = fmaxf(v[j], 0.f); v[j] = t * t * r2; }
                    st4(U + (size_t)row * FF + col0 + 128 * bj + 16 * n, v); } }
    }
};
struct EpiFF2 {
    static constexpr bool PERM = false, AFTER_DRAIN = false;
    float* X1;
    __device__ __forceinline__ void operator()(const f32x4 (&acc)[2][2][4][2], const pg8::Unit& u, int wr, int wc, int fr, int fq) const {
        const int row0 = u.pm * 256 + wr * 64 + fr; const int col0 = u.pn * 256 + wc * 32 + 4 * fq;
#pragma unroll
        EPI_ROWS(ai, m) { const size_t ro = (size_t)(row0 + 128 * ai + 16 * m) * 1024 + col0;
#pragma unroll
            for (int bj = 0; bj < 2; ++bj)
#pragma unroll
                for (int n = 0; n < 2; ++n) { float* p = X1 + ro + 128 * bj + 16 * n; *(f32x4*)p = *(const f32x4*)p + acc[ai][bj][m][n]; } }
    }
};

__device__ __forceinline__ int crow(int r, int hi) { return (r & 3) + 8 * (r >> 2) + 4 * hi; }
struct MobaAux { const unsigned short* list; int cnt; int chunk; bf16_t* part_o; float* part_ml; };
template <int DQK, int MODE>
__device__ __forceinline__ void attn_unit(int b, int h, int qb, const bf16_t* __restrict__ Qg, const bf16_t* __restrict__ Kg, const bf16_t* __restrict__ Vg, bf16_t* __restrict__ Og,
                                          const MobaAux ax, LAS unsigned char* lds) {
    constexpr int LDQ = 8 * DQK, ND = DQK / 16, KP = DQK * 2 + 16, VP = 144, KBYTES = 64 * KP, VBYTES = 64 * VP, VOFF = 2 * KBYTES, CTLOFF = 2 * KBYTES + 2 * VBYTES;
    constexpr int KCH = DQK / 8;
    constexpr bool MOBA = false;
    LAS int* tl = (LAS int*)(lds + CTLOFF + 64);
    int tid_ = threadIdx.x; asm volatile("" : "+v"(tid_));
    const int tid = tid_, lane = tid & 63, wid = __builtin_amdgcn_readfirstlane(tid >> 6), r32 = lane & 31, hi = lane >> 5;
    const size_t rowbase = (size_t)b * SEQ; const int q0 = qb * 256;
    int qrow_idx = q0 + wid * 32 + r32, slot = 0; bool valid = true;
    if constexpr (MODE == 1) { const int idx = ax.chunk * 256 + wid * 32 + r32; valid = idx < ax.cnt; const unsigned e_ = ax.list[valid ? idx : ax.cnt - 1]; qrow_idx = (int)(e_ & 8191u); slot = (int)(e_ >> 13); }
    bf16x8 qf[ND];
    { const bf16_t* qrow = Qg + (rowbase + qrow_idx) * LDQ + h * DQK + 8 * hi;
#pragma unroll
      for (int d0 = 0; d0 < ND; ++d0) qf[d0] = *(const bf16x8*)(qrow + 16 * d0); }
    const unsigned selmask = 0u;
    const unsigned um = (MODE != 0 || qb == 0) ? 0u : (0xffffffffu >> (32 - qb));
    const int tile0 = (MODE == 1) ? qb * 256 : q0;
    const int nblk = __builtin_popcount(um); const int nt = 4 * (nblk + 1);
    if (tid < 32) { if ((um >> tid) & 1u) { const int idx = __builtin_popcount(um & ((1u << tid) - 1u));
#pragma unroll
            for (int s = 0; s < 4; ++s) tl[4 * idx + s] = 256 * tid + 64 * s; } }
    else if (tid == 32) {
#pragma unroll
        for (int s = 0; s < 4; ++s) tl[4 * nblk + s] = tile0 + 64 * s; }
    __syncthreads();
    const int kr0 = (KCH == 8) ? (tid >> 3) : (tid / 12), kc0 = (KCH == 8) ? (tid & 7) : (tid % 12);
    const int kr1 = (tid + 512) / 12, kc1 = (tid + 512) % 12; const bool has2 = (KCH == 12) && (tid < 256); const int kr1c = has2 ? kr1 : kr0;
    const bf16_t* Kh = Kg + rowbase * LDQ + h * DQK; const bf16_t* Vh = Vg + rowbase * 512 + h * 64;
    const int vkv = tid & 63, vdg = tid >> 6;
    const int vpos = (vkv & ~15) | (((vkv >> 2) & 1) << 3) | (((vkv >> 3) & 1) << 2) | (vkv & 3);
    u32x4 kA0, kA1 = (u32x4){0u, 0u, 0u, 0u}, vA, kB0, kB1 = (u32x4){0u, 0u, 0u, 0u}, vB;
#define ATT_LOADK(K0, K1, kv0) do { K0 = *(const u32x4*)(Kh + (size_t)((kv0) + kr0) * LDQ + 8 * kc0); if constexpr (KCH == 12) K1 = *(const u32x4*)(Kh + (size_t)((kv0) + kr1c) * LDQ + 8 * kc1); } while (0)
#define ATT_LOADV(V_, kv0) do { V_ = *(const u32x4*)(Vh + (size_t)((kv0) + vkv) * 512 + 8 * vdg); } while (0)
#define ATT_STOREK(K0, K1, buf) do { LAS unsigned char* kb_ = lds + (buf) * KBYTES; *(LAS u32x4*)(kb_ + kr0 * KP + 16 * kc0) = K0; if (has2) *(LAS u32x4*)(kb_ + kr1 * KP + 16 * kc1) = K1; } while (0)
#define ATT_STOREV(V_, buf) do { LAS unsigned char* vb_ = lds + VOFF + (buf) * VBYTES + (8 * vdg) * VP + 2 * vpos; \
        *(LAS unsigned short*)(vb_ + 0 * VP) = (unsigned short)(V_.x & 0xffffu); *(LAS unsigned short*)(vb_ + 1 * VP) = (unsigned short)(V_.x >> 16); \
        *(LAS unsigned short*)(vb_ + 2 * VP) = (unsigned short)(V_.y & 0xffffu); *(LAS unsigned short*)(vb_ + 3 * VP) = (unsigned short)(V_.y >> 16); \
        *(LAS unsigned short*)(vb_ + 4 * VP) = (unsigned short)(V_.z & 0xffffu); *(LAS unsigned short*)(vb_ + 5 * VP) = (unsigned short)(V_.z >> 16); \
        *(LAS unsigned short*)(vb_ + 6 * VP) = (unsigned short)(V_.w & 0xffffu); *(LAS unsigned short*)(vb_ + 7 * VP) = (unsigned short)(V_.w >> 16); } while (0)
#define ATT_QK(S0, S1, kbuf) do { const LAS unsigned char* kb_ = lds + (kbuf) * KBYTES + r32 * KP + (8 * hi) * 2; \
        S0 = __builtin_amdgcn_mfma_f32_32x32x16_bf16(*(const LAS bf16x8*)(kb_), qf[0], cinit, 0, 0, 0); \
        S1 = __builtin_amdgcn_mfma_f32_32x32x16_bf16(*(const LAS bf16x8*)(kb_ + 32 * KP), qf[0], cinit, 0, 0, 0); \
        _Pragma("unroll") for (int d0 = 1; d0 < ND; ++d0) { \
            S0 = __builtin_amdgcn_mfma_f32_32x32x16_bf16(*(const LAS bf16x8*)(kb_ + 32 * d0), qf[d0], S0, 0, 0, 0); \
            S1 = __builtin_amdgcn_mfma_f32_32x32x16_bf16(*(const LAS bf16x8*)(kb_ + 32 * KP + 32 * d0), qf[d0], S1, 0, 0, 0); } } while (0)
    f32x16 o0, o1, cinit;
#pragma unroll
    for (int r = 0; r < 16; ++r) { o0[r] = 0.f; o1[r] = 0.f; cinit[r] = 0.f; }
    float lrun = 0.f, negm = 0.f; bool started = false; int curblk = -1;
#define ATT_CINIT(kvpos) do { if constexpr (MOBA) { const int blk_ = (kvpos) >> 8; if (blk_ != curblk) { curblk = blk_; const float cv_ = (blk_ == qb || ((selmask >> blk_) & 1u)) ? negm : -INFINITY; \
        _Pragma("unroll") for (int r = 0; r < 16; ++r) cinit[r] = cv_; } } } while (0)
    ATT_LOADK(kA0, kA1, tl[0]); ATT_LOADV(vA, tl[0]); ATT_STOREK(kA0, kA1, 0); ATT_STOREV(vA, 0);
    ATT_LOADK(kA0, kA1, tl[1]);
    __syncthreads();
    f32x16 s0, s1;
    ATT_CINIT(tl[0]);
    ATT_QK(s0, s1, 0);
    ATT_STOREK(kA0, kA1, 1);
    ATT_LOADK(kB0, kB1, tl[2]); ATT_LOADV(vB, tl[1]);
    __syncthreads();
    auto body = [&](const int it, u32x4& LK0, u32x4& LK1, u32x4& LV, const u32x4& SK0, const u32x4& SK1, const u32x4& SV) __attribute__((always_inline)) {
        const int kv0 = tl[it]; const bool diag = (MODE == 1) ? false : ((kv0 >> 8) == qb);
        const bool n1 = (it + 1 < nt);
        { const int kvk = tl[(it + 3 < nt) ? it + 3 : nt - 1], kvv = tl[(it + 2 < nt) ? it + 2 : nt - 1]; ATT_LOADK(LK0, LK1, kvk); ATT_LOADV(LV, kvv); }
        if (diag) { const int qrel = 32 * wid + r32 - (kv0 - q0);
#pragma unroll
            for (int r = 0; r < 16; ++r) { const int kvr = crow(r, hi); if (kvr > qrel) s0[r] = -INFINITY; if (kvr + 32 > qrel) s1[r] = -INFINITY; } }
        float mxa = __builtin_fmaxf(__builtin_fmaxf(s0[0], s0[1]), s1[0]), mxb = __builtin_fmaxf(__builtin_fmaxf(s0[2], s0[3]), s1[1]);
        mxa = __builtin_fmaxf(__builtin_fmaxf(mxa, s1[2]), s1[3]);
#pragma unroll
        for (int r = 4; r < 16; r += 4) { mxa = __builtin_fmaxf(__builtin_fmaxf(mxa, s0[r]), s0[r + 1]); mxb = __builtin_fmaxf(__builtin_fmaxf(mxb, s0[r + 2]), s0[r + 3]);
            mxa = __builtin_fmaxf(__builtin_fmaxf(mxa, s1[r]), s1[r + 1]); mxb = __builtin_fmaxf(__builtin_fmaxf(mxb, s1[r + 2]), s1[r + 3]); }
        float mx = __builtin_fmaxf(mxa, mxb);
        { auto rr = __builtin_amdgcn_permlane32_swap(__float_as_uint(mx), __float_as_uint(mx), false, false); mx = __builtin_fmaxf(__uint_as_float(rr[0]), __uint_as_float(rr[1])); }
        const bool need = started ? (mx > 8.f) : (mx > -INFINITY);
        if (__any(need)) {
            const float dl = need ? mx : 0.f; started = started || need;
            negm -= dl;
#pragma unroll
            for (int r = 0; r < 16; ++r) { s0[r] -= dl; s1[r] -= dl; cinit[r] -= dl; }
            const float alpha = __builtin_amdgcn_exp2f(-dl); lrun *= alpha;
#pragma unroll
            for (int r = 0; r < 16; ++r) { o0[r] *= alpha; o1[r] *= alpha; }
        }
        f32x16 t0, t1;
        { const int kvn = n1 ? tl[it + 1] : kv0; ATT_CINIT(kvn); }
        ATT_QK(t0, t1, (it + 1) & 1);
        f32x2_t ls2 = {0.f, 0.f};
#pragma unroll
        for (int r = 0; r < 16; ++r) { s0[r] = __builtin_amdgcn_exp2f(s0[r]); s1[r] = __builtin_amdgcn_exp2f(s1[r]); }
#pragma unroll
        for (int r = 0; r < 16; r += 2) { ls2 += (f32x2_t){s0[r], s0[r + 1]}; ls2 += (f32x2_t){s1[r], s1[r + 1]}; }
        lrun += ls2.x + ls2.y;
        const LAS unsigned char* vb = lds + VOFF + (it & 1) * VBYTES;
#pragma unroll
        for (int kt = 0; kt < 2; ++kt)
#pragma unroll
            for (int uu = 0; uu < 2; ++uu) {
                u32x4 pw;
                if (kt == 0) { pw.x = cvtpk(s0[8 * uu + 0], s0[8 * uu + 1]); pw.y = cvtpk(s0[8 * uu + 2], s0[8 * uu + 3]); pw.z = cvtpk(s0[8 * uu + 4], s0[8 * uu + 5]); pw.w = cvtpk(s0[8 * uu + 6], s0[8 * uu + 7]); }
                else         { pw.x = cvtpk(s1[8 * uu + 0], s1[8 * uu + 1]); pw.y = cvtpk(s1[8 * uu + 2], s1[8 * uu + 3]); pw.z = cvtpk(s1[8 * uu + 4], s1[8 * uu + 5]); pw.w = cvtpk(s1[8 * uu + 6], s1[8 * uu + 7]); }
                const bf16x8 pb = __builtin_bit_cast(bf16x8, pw);
                const int kvo = (32 * kt + 16 * uu + 8 * hi) * 2;
#pragma unroll
                for (int dt = 0; dt < 2; ++dt) {
                    const bf16x8 va = *(const LAS bf16x8*)(vb + (32 * dt + r32) * VP + kvo);
                    if (dt == 0) o0 = __builtin_amdgcn_mfma_f32_32x32x16_bf16(va, pb, o0, 0, 0, 0); else o1 = __builtin_amdgcn_mfma_f32_32x32x16_bf16(va, pb, o1, 0, 0, 0);
                }
            }
        ATT_STOREK(SK0, SK1, it & 1);
        ATT_STOREV(SV, (it + 1) & 1);
        __syncthreads();
        s0 = t0; s1 = t1;
    };
    for (int it = 0; it < nt; it += 2) { body(it, kA0, kA1, vA, kB0, kB1, vB); body(it + 1, kB0, kB1, vB, kA0, kA1, vA); }
#undef ATT_LOADK
#undef ATT_LOADV
#undef ATT_STOREK
#undef ATT_STOREV
#undef ATT_QK
#undef ATT_CINIT
    lrun += __shfl_xor(lrun, 32);
    if constexpr (MODE == 1) {
        const float inv = 1.f / lrun;
        if (valid) {
            const size_t pidx = ((size_t)(b * 8 + h) * SEQ + qrow_idx) * 3 + slot;
            bf16_t* po = ax.part_o + pidx * 64 + 4 * hi;
#pragma unroll
            for (int g = 0; g < 4; ++g) {
                st4(po + 8 * g, (f32x4){o0[4 * g] * inv, o0[4 * g + 1] * inv, o0[4 * g + 2] * inv, o0[4 * g + 3] * inv});
                st4(po + 32 + 8 * g, (f32x4){o1[4 * g] * inv, o1[4 * g + 1] * inv, o1[4 * g + 2] * inv, o1[4 * g + 3] * inv});
            }
            if (hi == 0) { f32x2_t ml = {-negm, lrun}; *(f32x2_t*)(ax.part_ml + pidx * 2) = ml; }
        }
        return;
    }
    if constexpr (MODE == 2) {
        const int nsel = qb < 3 ? qb : 3;
        const size_t pbase = ((size_t)(b * 8 + h) * SEQ + qrow_idx) * 3;
        const float mref = -negm; float mm = mref;
        for (int s = 0; s < nsel; ++s) mm = __builtin_fmaxf(mm, ax.part_ml[(pbase + s) * 2]);
        const float w0 = __builtin_amdgcn_exp2f(mref - mm); lrun *= w0;
#pragma unroll
        for (int r = 0; r < 16; ++r) { o0[r] *= w0; o1[r] *= w0; }
        for (int s = 0; s < nsel; ++s) {
            const f32x2_t ml = *(const f32x2_t*)(ax.part_ml + (pbase + s) * 2);
            const float w = __builtin_amdgcn_exp2f(ml.x - mm) * ml.y; lrun += w;
            const bf16_t* po = ax.part_o + (pbase + s) * 64 + 4 * hi;
#pragma unroll
            for (int g = 0; g < 4; ++g) { const f32x4 a_ = ld4bf(po + 8 * g), c_ = ld4bf(po + 32 + 8 * g);
#pragma unroll
                for (int k = 0; k < 4; ++k) { o0[4 * g + k] += w * a_[k]; o1[4 * g + k] += w * c_[k]; } }
        }
    }
    const float inv = 1.f / lrun;
    bf16_t* orow = Og + (rowbase + q0 + wid * 32 + r32) * 512 + h * 64 + 4 * hi;
#pragma unroll
    for (int g = 0; g < 4; ++g) {
        st4(orow + 8 * g, (f32x4){o0[4 * g] * inv, o0[4 * g + 1] * inv, o0[4 * g + 2] * inv, o0[4 * g + 3] * inv});
        st4(orow + 32 + 8 * g, (f32x4){o1[4 * g] * inv, o1[4 * g + 1] * inv, o1[4 * g + 2] * inv, o1[4 * g + 3] * inv});
    }
}

__device__ __forceinline__ int moba_loff(int j) { return 7936 * j - 128 * j * (j - 1); }
constexpr int MOBA_LIST_PER_BH = 126976;
__device__ __forceinline__ void moba_select(const bf16_t* __restrict__ QA, const float* __restrict__ KMEAN, unsigned* CNT, unsigned short* LIST, int gid, LAS float* kms) {
    const int bh = gid >> 13, q = gid & 8191, b = bh >> 3, h = bh & 7, qb = q >> 8;
    { const int t_ = threadIdx.x; const int qbmax = (((gid - t_) & 8191) >> 8) + 1;
      __syncthreads();
      for (int i = t_; i < qbmax * 16; i += NTHREADS) { const int j = i >> 4, c = i & 15; *(LAS f32x4*)(kms + j * 64 + 4 * c) = *(const f32x4*)(KMEAN + (size_t)(b * 32 + j) * 512 + h * 64 + 4 * c); }
      __syncthreads(); }
    if (qb == 0) return;
    float qv[64];
    { const u32x4* qp = (const u32x4*)(QA + ((size_t)b * SEQ + q) * 512 + h * 64);
#pragma unroll
      for (int c = 0; c < 8; ++c) { const u32x4 w = qp[c];
          qv[8 * c + 0] = __uint_as_float(w.x << 16); qv[8 * c + 1] = __uint_as_float(w.x & 0xffff0000u); qv[8 * c + 2] = __uint_as_float(w.y << 16); qv[8 * c + 3] = __uint_as_float(w.y & 0xffff0000u);
          qv[8 * c + 4] = __uint_as_float(w.z << 16); qv[8 * c + 5] = __uint_as_float(w.z & 0xffff0000u); qv[8 * c + 6] = __uint_as_float(w.w << 16); qv[8 * c + 7] = __uint_as_float(w.w & 0xffff0000u); } }
    float v1 = -INFINITY, v2 = -INFINITY, v3 = -INFINITY; int i1 = -1, i2 = -1, i3 = -1;
    for (int j = 0; j < qb; ++j) {
        const LAS f32x4* km = (const LAS f32x4*)(kms + j * 64); float s0 = 0.f, s1 = 0.f;
#pragma unroll
        for (int c = 0; c < 16; c += 2) { const f32x4 a_ = km[c], c_ = km[c + 1];
            s0 += qv[4 * c] * a_[0] + qv[4 * c + 1] * a_[1] + qv[4 * c + 2] * a_[2] + qv[4 * c + 3] * a_[3];
            s1 += qv[4 * c + 4] * c_[0] + qv[4 * c + 5] * c_[1] + qv[4 * c + 6] * c_[2] + qv[4 * c + 7] * c_[3]; }
        const float s = s0 + s1;
        if (s > v1) { v3 = v2; i3 = i2; v2 = v1; i2 = i1; v1 = s; i1 = j; }
        else if (s > v2) { v3 = v2; i3 = i2; v2 = s; i2 = j; }
        else if (s > v3) { v3 = s; i3 = j; }
    }
    unsigned short* lb = LIST + (size_t)bh * MOBA_LIST_PER_BH;
    const int lane = gid & 63; int myn = 0;
    for (int j = 0; j < qb; ++j) { const unsigned long long m = __ballot((i1 == j) | (i2 == j) | (i3 == j)); if (lane == j) myn = __popcll(m); }
    unsigned mybase = 0u;
    if (lane < qb && myn > 0) mybase = atomicAdd(CNT + bh * 32 + lane, (unsigned)myn);
    for (int j = 0; j < qb; ++j) {
        const bool pick = (i1 == j) | (i2 == j) | (i3 == j); const unsigned long long m = __ballot(pick); const unsigned base = (unsigned)__shfl((int)mybase, j);
        if (pick) { const int rank = __popcll(m & ((1ull << lane) - 1ull)); const int slot_ = (i1 == j) ? 0 : (i2 == j) ? 1 : 2; lb[moba_loff(j) + base + rank] = (unsigned short)(q | (slot_ << 13)); }
    }
}

__device__ __forceinline__ int win_src_col(int p) {
    if (p < 1024) { const int base = p & ~63, w = p & 63, g = w >> 5, ww = w & 31; return base + (ww < 16 ? 16 * g + ww : 32 + 16 * g + (ww - 16)); }
    if (p < 2208) return p;
    if (p < 2304) return -1;
    return p - 96;
}
__device__ __forceinline__ void transpose_item(const float* __restrict__ W, int K, int Nsrc, int nblk, bf16_t* WT, const float* gk, bool winmap, LAS float* scr, int item, int lane) {
    const int kb = item / nblk, nb = item % nblk, k0 = 64 * kb, n0 = 32 * nb;
    const int np = n0 + (lane & 31); const int sc = winmap ? win_src_col(np) : np;
#pragma unroll 8
    for (int i = 0; i < 32; ++i) { const int kk = 2 * i + (lane >> 5); float v = (sc >= 0) ? W[(size_t)(k0 + kk) * Nsrc + sc] : 0.f; if (gk) v *= gk[k0 + kk]; scr[kk * 33 + (lane & 31)] = v; }
    asm volatile("s_waitcnt lgkmcnt(0)" ::: "memory");
    const int c = lane & 7;
#pragma unroll
    for (int j = 0; j < 4; ++j) { const int n = (lane >> 3) + 8 * j; const LAS float* s = scr + (8 * c) * 33 + n;
        u32x4 o; o.x = cvtpk(s[0 * 33], s[1 * 33]); o.y = cvtpk(s[2 * 33], s[3 * 33]); o.z = cvtpk(s[4 * 33], s[5 * 33]); o.w = cvtpk(s[6 * 33], s[7 * 33]);
        *(u32x4*)(WT + (size_t)(n0 + n) * K + k0 + 8 * c) = o; }
    asm volatile("s_waitcnt lgkmcnt(0)" ::: "memory");
}

#define GRID_SYNC() xcd_barrier(xbar)
struct Args { const float* in[15]; float* out; unsigned char* ws; };

__global__ void __launch_bounds__(NTHREADS, 2) fwd_megakernel(Args a) {
    extern __shared__ __attribute__((aligned(16))) unsigned char lds_raw[];
    LAS unsigned char* lds = (LAS unsigned char*)lds_raw;
    cg::grid_group grid = cg::this_grid();
    if (a.ws == nullptr) grid.sync();
    volatile LAS unsigned* MISC = (volatile LAS unsigned*)(lds + 131072 + 320);
    if (threadIdx.x < 32) MISC[threadIdx.x] = 0u;
    __syncthreads();
    XcdBarrier xbar = xcd_barrier_post((unsigned*)(a.ws + WS_BAR), MISC + 8);
    const int G = gridDim.x, bx = blockIdx.x; const int vcu = (G % 8 == 0) ? (bx % 8) * (G / 8) + bx / 8 : bx;
#if defined(PROBE_P0)
    for (int rep_ = 0; rep_ < 2; ++rep_)
#endif
    {
        unsigned char* wsl = a.ws; asm volatile("" : "+s"(wsl));
        float* ROPE64 = (float*)(wsl + WS_ROPE64); float* ROPE32 = (float*)(wsl + WS_ROPE32); bf16_t* WIN = (bf16_t*)(wsl + WS_WIN); bf16_t* WQUP = (bf16_t*)(wsl + WS_WQUP); bf16_t* WKVUP = (bf16_t*)(wsl + WS_WKVUP); bf16_t* WOA = (bf16_t*)(wsl + WS_WOA); bf16_t* WOB = (bf16_t*)(wsl + WS_WOB); bf16_t* WOUT = (bf16_t*)(wsl + WS_WOUT); bf16_t* WFF1 = (bf16_t*)(wsl + WS_WFF1); bf16_t* WFF2 = (bf16_t*)(wsl + WS_WFF2); bf16_t* XN = (bf16_t*)(wsl + WS_XN); const float* x = a.in[0]; const float* g_mix = a.in[1]; const float* w_in = a.in[2]; const float* g_cq = a.in[4]; const float* w_q_up = a.in[5]; const float* g_ckv = a.in[6]; const float* w_kv_up = a.in[7]; const float* w_o_a = a.in[8]; const float* w_o_b = a.in[9]; const float* w_out = a.in[10]; const float* g_mlp = a.in[11]; const float* w_ff1 = a.in[12]; const float* w_ff2 = a.in[13];
        unsigned char* ws = wsl;
        int tid_ = threadIdx.x; asm volatile("" : "+v"(tid_)); const int tid = tid_, lane = tid & 63, wave = __builtin_amdgcn_readfirstlane(tid >> 6);
        const int gw = vcu * 8 + wave, NGW = G * 8;
        const int gt = bx * NTHREADS + tid, NGT = G * NTHREADS;
        for (int i = gt; i < (int)(WS_CTL_END / 4); i += NGT) ((float*)ws)[i] = 0.f;
        for (int i = gt; i < SEQ * 32; i += NGT) { const int pos = i >> 5, f = i & 31; const float inv = __builtin_amdgcn_exp2f(-(float)f * (13.287712379549449f / 32.f)); const float ang = (float)pos * inv;
            double rev = (double)ang * 0.15915494309189535; rev -= __builtin_rint(rev); const float fr = (float)rev;
            ROPE64[2 * i] = __builtin_amdgcn_cosf(fr); ROPE64[2 * i + 1] = __builtin_amdgcn_sinf(fr); }
        for (int i = gt; i < SEQ * 16; i += NGT) { const int pos = i >> 4, f = i & 15; const float inv = __builtin_amdgcn_exp2f(-(float)f * (13.287712379549449f / 16.f)); const float ang = (float)pos * inv;
            double rev = (double)ang * 0.15915494309189535; rev -= __builtin_rint(rev); const float fr = (float)rev;
            ROPE32[2 * i] = __builtin_amdgcn_cosf(fr); ROPE32[2 * i + 1] = __builtin_amdgcn_sinf(fr); }
        LAS float* scr = (LAS float*)(lds + wave * 16384);
        constexpr int I_IN = 16 * 136, I_QUP = 6 * 24, I_KVUP = 4 * 32, I_OA = 8 * 32, I_OUT = 16 * 32, I_FF1 = 16 * 128, I_FF2 = 64 * 32;
        constexpr int NITEMS = I_IN + I_QUP + I_KVUP + 2 * I_OA + I_OUT + I_FF1 + I_FF2;
        for (int it = gw; it < NITEMS; it += NGW) {
            int r = it;
            if (r < I_IN) { transpose_item(w_in, 1024, 4256, 136, WIN, nullptr, true, scr, r, lane); continue; } r -= I_IN;
            if (r < I_QUP) { transpose_item(w_q_up, 384, 768, 24, WQUP, g_cq, false, scr, r, lane); continue; } r -= I_QUP;
            if (r < I_KVUP) { transpose_item(w_kv_up, 256, 1024, 32, WKVUP, g_ckv, false, scr, r, lane); continue; } r -= I_KVUP;
            if (r < I_OA) { transpose_item(w_o_a, 512, 1024, 32, WOA, nullptr, false, scr, r, lane); continue; } r -= I_OA;
            if (r < I_OA) { transpose_item(w_o_b, 512, 1024, 32, WOB, nullptr, false, scr, r, lane); continue; } r -= I_OA;
            if (r < I_OUT) { transpose_item(w_out, 1024, 1024, 32, WOUT, nullptr, false, scr, r, lane); continue; } r -= I_OUT;
            if (r < I_FF1) { transpose_item(w_ff1, 1024, 4096, 128, WFF1, g_mlp, false, scr, r, lane); continue; } r -= I_FF1;
            transpose_item(w_ff2, 4096, 1024, 32, WFF2, nullptr, false, scr, r, lane);
        }
        f32x4 gm[4];
#pragma unroll
        for (int j = 0; j < 4; ++j) gm[j] = *((const f32x4*)g_mix + lane + 64 * j);
        for (int m = gw; m < M; m += NGW) {
            const f32x4* xr = (const f32x4*)(x + (size_t)m * DM) + lane; f32x4 v[4]; float s = 0.f;
#pragma unroll
            for (int j = 0; j < 4; ++j) { v[j] = xr[64 * j]; s += (v[j][0] * v[j][0] + v[j][1] * v[j][1]) + (v[j][2] * v[j][2] + v[j][3] * v[j][3]); }
            const float rs = rsqrtf(wave_sum(s) * (1.f / DM) + EPS);
#pragma unroll
            for (int j = 0; j < 4; ++j) st4(XN + (size_t)m * DM + 4 * (lane + 64 * j), v[j] * rs * gm[j]);
        }
    }
    GRID_SYNC();
    {
        unsigned char* wsl = a.ws; asm volatile("" : "+s"(wsl));
        bf16_t* XN = (bf16_t*)(wsl + WS_XN); bf16_t* WIN = (bf16_t*)(wsl + WS_WIN); bf16_t* QA = (bf16_t*)(wsl + WS_QA); bf16_t* KA = (bf16_t*)(wsl + WS_KA); bf16_t* VA = (bf16_t*)(wsl + WS_VA); bf16_t* CQ = (bf16_t*)(wsl + WS_CQ); bf16_t* CKV = (bf16_t*)(wsl + WS_CKV); bf16_t* KB = (bf16_t*)(wsl + WS_KB); bf16_t* GT = (bf16_t*)a.out; float* ROWSS_Q = (float*)(wsl + WS_ROWSS_Q); float* ROWSS_KV = (float*)(wsl + WS_ROWSS_KV); float* KMEAN = (float*)(wsl + WS_KMEAN); float* ROPE64 = (float*)(wsl + WS_ROPE64); float* ROPE32 = (float*)(wsl + WS_ROPE32); const float* b_gate = a.in[3];
      pg8::Gemm g{XN, WIN, M, NIN, 1024}; pg8::StaticOrder S; S.init(M, NIN, G, bx);
      EpiProj E{QA, KA, VA, CQ, CKV, KB, GT, ROWSS_Q, ROWSS_KV, KMEAN, ROPE64, ROPE32, b_gate};
      pg8::gemm_phase<EpiProj, pg8::StaticOrder, true, true>(lds, g, S, E); }
    GRID_SYNC();
    {
        unsigned char* wsl = a.ws; asm volatile("" : "+s"(wsl));
        int tid_ = threadIdx.x; asm volatile("" : "+v"(tid_));
        for (int gid = bx * NTHREADS + tid_; gid < 16 * SEQ; gid += G * NTHREADS)
            moba_select((const bf16_t*)(wsl + WS_QA), (const float*)(wsl + WS_KMEAN), (unsigned*)(wsl + WS_CNT), (unsigned short*)(wsl + WS_LIST), gid, (LAS float*)lds);
        __syncthreads();
    }
    {
        unsigned char* wsl = a.ws; asm volatile("" : "+s"(wsl));
        bf16_t* CQ = (bf16_t*)(wsl + WS_CQ); bf16_t* WQUP = (bf16_t*)(wsl + WS_WQUP); bf16_t* QB = (bf16_t*)(wsl + WS_QB); float* ROWSS_Q = (float*)(wsl + WS_ROWSS_Q); float* ROPE32 = (float*)(wsl + WS_ROPE32);
      pg8::Gemm g{CQ, WQUP, M, 768, 384}; pg8::StaticOrder S; S.init(M, 768, G, bx); EpiQup E{QB, ROWSS_Q, ROPE32};
      pg8::gemm_phase<EpiQup, pg8::StaticOrder, true, true>(lds, g, S, E); }
    __syncthreads();
    {
        unsigned char* wsl = a.ws; asm volatile("" : "+s"(wsl));
        bf16_t* CKV = (bf16_t*)(wsl + WS_CKV); bf16_t* WKVUP = (bf16_t*)(wsl + WS_WKVUP); bf16_t* KB = (bf16_t*)(wsl + WS_KB); bf16_t* VB = (bf16_t*)(wsl + WS_VB); float* ROWSS_KV = (float*)(wsl + WS_ROWSS_KV);
      pg8::Gemm g{CKV, WKVUP, M, 1024, 256}; pg8::StaticOrder S; S.init(M, 1024, G, bx); EpiKVup E{KB, VB, ROWSS_KV};
      pg8::gemm_phase<EpiKVup, pg8::StaticOrder, true, true>(lds, g, S, E); }
    GRID_SYNC();
    {
        unsigned char* wsl = a.ws; asm volatile("" : "+s"(wsl));
        bf16_t *QB = (bf16_t*)(wsl + WS_QB), *KB = (bf16_t*)(wsl + WS_KB), *VB = (bf16_t*)(wsl + WS_VB), *OB = (bf16_t*)(wsl + WS_OB);
        bf16_t *QA = (bf16_t*)(wsl + WS_QA), *KA = (bf16_t*)(wsl + WS_KA), *VA = (bf16_t*)(wsl + WS_VA), *OA = (bf16_t*)(wsl + WS_OA);
        const unsigned* CNT = (const unsigned*)(wsl + WS_CNT); const unsigned short* LIST = (const unsigned short*)(wsl + WS_LIST);
        bf16_t* PART_O = (bf16_t*)(wsl + WS_PART_O); float* PART_ML = (float*)(wsl + WS_PART_ML);
        const MobaAux ax0{nullptr, 0, 0, PART_O, PART_ML};
#if defined(PROBE_REP)
        for (int rep_ = 0; rep_ < 2; ++rep_)
#endif
        for (int p = vcu; p < 256; p += G) {
            const int bh = p >> 4, s = p & 15, b = bh >> 3, h = bh & 7;
            attn_unit<96, 0>(b, h, 31 - s, QB, KB, VB, OB, ax0, lds); attn_unit<96, 0>(b, h, s, QB, KB, VB, OB, ax0, lds);
        }
        LAS int* pre = (LAS int*)(lds + 120000);
        { int tid_ = threadIdx.x; asm volatile("" : "+v"(tid_));
          if (tid_ < 64) { int c[8], sum = 0;
#pragma unroll
              for (int k = 0; k < 8; ++k) { const int t_ = 8 * tid_ + k; c[k] = (t_ < 496) ? (int)((CNT[(t_ / 31) * 32 + (t_ % 31)] + 255u) >> 8) : 0; sum += c[k]; }
              int incl = sum;
#pragma unroll
              for (int o = 1; o < 64; o <<= 1) { const int v = __shfl_up(incl, o); if (tid_ >= o) incl += v; }
              int run = incl - sum;
#pragma unroll
              for (int k = 0; k < 8; ++k) { const int t_ = 8 * tid_ + k; if (t_ <= 496) pre[t_] = run; run += c[k]; }
          }
          __syncthreads(); }
        const int nitems = pre[496];
#if defined(PROBE_GATHER)
        for (int rep2_ = 0; rep2_ < 2; ++rep2_)
#endif
        for (int I = vcu; I < nitems; I += G) {
            int lo = 0, hi_ = 496;
            while (hi_ - lo > 1) { const int mid = (lo + hi_) >> 1; if (pre[mid] <= I) lo = mid; else hi_ = mid; }
            const int bh = lo / 31, j = lo % 31;
            const MobaAux ax{LIST + (size_t)bh * MOBA_LIST_PER_BH + moba_loff(j), (int)CNT[bh * 32 + j], I - pre[lo], PART_O, PART_ML};
            attn_unit<64, 1>(bh >> 3, bh & 7, j, QA, KA, VA, OA, ax, lds);
        }
        GRID_SYNC();
#if defined(PROBE_OWN)
        for (int rep3_ = 0; rep3_ < 2; ++rep3_)
#endif
        for (int p = vcu; p < 512; p += G) attn_unit<64, 2>(p >> 8, (p >> 5) & 7, p & 31, QA, KA, VA, OA, ax0, lds);
    }
    GRID_SYNC();
    {
        unsigned char* wsl = a.ws; asm volatile("" : "+s"(wsl));
        bf16_t* OA = (bf16_t*)(wsl + WS_OA); bf16_t* WOA = (bf16_t*)(wsl + WS_WOA); bf16_t* Z = (bf16_t*)(wsl + WS_Z); bf16_t* GT = (bf16_t*)a.out;
      pg8::Gemm g{OA, WOA, M, 1024, 512}; pg8::StaticOrder S; S.init(M, 1024, G, bx); EpiGate<false> E{Z, GT};
      pg8::gemm_phase<EpiGate<false>, pg8::StaticOrder, true, true>(lds, g, S, E); }
    __syncthreads();
    {
        unsigned char* wsl = a.ws; asm volatile("" : "+s"(wsl));
        bf16_t* OB = (bf16_t*)(wsl + WS_OB); bf16_t* WOB = (bf16_t*)(wsl + WS_WOB); bf16_t* Z = (bf16_t*)(wsl + WS_Z); bf16_t* GT = (bf16_t*)a.out;
      pg8::Gemm g{OB, WOB, M, 1024, 512}; pg8::StaticOrder S; S.init(M, 1024, G, bx); EpiGate<true> E{Z, GT + (size_t)M * 1024};
      pg8::gemm_phase<EpiGate<true>, pg8::StaticOrder, true, true>(lds, g, S, E); }
    GRID_SYNC();
    {
        unsigned char* wsl = a.ws; asm volatile("" : "+s"(wsl));
        bf16_t* Z = (bf16_t*)(wsl + WS_Z); bf16_t* WOUT = (bf16_t*)(wsl + WS_WOUT); const float* x = a.in[0]; float* out = a.out; bf16_t* X1B = (bf16_t*)(wsl + WS_X1B); float* ROWSS2 = (float*)(wsl + WS_ROWSS2);
      pg8::Gemm g{Z, WOUT, M, 1024, 1024}; pg8::StaticOrder S; S.init(M, 1024, G, bx); EpiOut E{x, out, X1B, ROWSS2};
      pg8::gemm_phase<EpiOut, pg8::StaticOrder, true, true>(lds, g, S, E); }
    GRID_SYNC();
#if defined(PROBE_P6)
    for (int rep_ = 0; rep_ < 2; ++rep_)
#endif
    {
        unsigned char* wsl = a.ws; asm volatile("" : "+s"(wsl));
        bf16_t* X1B = (bf16_t*)(wsl + WS_X1B); bf16_t* WFF1 = (bf16_t*)(wsl + WS_WFF1); bf16_t* U = (bf16_t*)(wsl + WS_U); float* ROWSS2 = (float*)(wsl + WS_ROWSS2);
      pg8::Gemm g{X1B, WFF1, M, FF, 1024}; pg8::StaticOrder S; S.init(M, FF, G, bx); EpiFF1 E{U, ROWSS2};
      pg8::gemm_phase<EpiFF1, pg8::StaticOrder, true, true>(lds, g, S, E); __syncthreads(); }
    GRID_SYNC();
    {
        unsigned char* wsl = a.ws; asm volatile("" : "+s"(wsl));
        bf16_t* U = (bf16_t*)(wsl + WS_U); bf16_t* WFF2 = (bf16_t*)(wsl + WS_WFF2); float* out = a.out;
      pg8::Gemm g{U, WFF2, M, 1024, FF}; pg8::StaticOrder S; S.init(M, 1024, G, bx); EpiFF2 E{out};
      pg8::gemm_phase<EpiFF2, pg8::StaticOrder, true, true>(lds, g, S, E); }
    GRID_SYNC();
    {
        float* out = a.out; const float* g_final = a.in[14];
        int tid_ = threadIdx.x; asm volatile("" : "+v"(tid_)); const int tid = tid_, lane = tid & 63, wave = __builtin_amdgcn_readfirstlane(tid >> 6);
        const int gw = vcu * 8 + wave, NGW = G * 8;
        f32x4 gf[4];
#pragma unroll
        for (int j = 0; j < 4; ++j) gf[j] = *((const f32x4*)g_final + lane + 64 * j);
        for (int m = gw; m < M; m += NGW) {
            f32x4* xr = (f32x4*)(out + (size_t)m * DM) + lane; f32x4 v[4]; float s = 0.f;
#pragma unroll
            for (int j = 0; j < 4; ++j) { v[j] = xr[64 * j]; s += (v[j][0] * v[j][0] + v[j][1] * v[j][1]) + (v[j][2] * v[j][2] + v[j][3] * v[j][3]); }
            const float rs = rsqrtf(wave_sum(s) * (1.f / DM) + EPS);
#pragma unroll
            for (int j = 0; j < 4; ++j) xr[64 * j] = v[j] * rs * gf[j];
        }
    }
}

extern "C" void kernel_launch(void* const* d_in, const int* in_sizes, int n_in, void* d_out, int out_size, void* d_ws, size_t ws_size, hipStream_t stream) {
    static int grid = 0;
    if (grid == 0) {
        if (n_in != 15 || out_size != M * DM || ws_size < WS_END) { fprintf(stderr, "kernel_launch: unexpected shapes (n_in %d out %d ws %zu)\n", n_in, out_size, ws_size); grid = -1; return; }
        int dev = 0, cus = 0, per_cu = 0;
        hipGetDevice(&dev); hipDeviceGetAttribute(&cus, hipDeviceAttributeMultiprocessorCount, dev);
        if (hipFuncSetAttribute((const void*)fwd_megakernel, hipFuncAttributeMaxDynamicSharedMemorySize, LDS_BYTES) != hipSuccess) { fprintf(stderr, "kernel_launch: hipFuncSetAttribute failed\n"); grid = -1; return; }
        if (hipOccupancyMaxActiveBlocksPerMultiprocessor(&per_cu, (const void*)fwd_megakernel, NTHREADS, LDS_BYTES) != hipSuccess || per_cu < 1) { fprintf(stderr, "kernel_launch: occupancy query gave %d\n", per_cu); per_cu = 1; }
        (void)hipGetLastError();
        grid = cus * per_cu;
    }
    if (grid < 0) return;
    if (hipMemsetAsync((char*)d_ws + WS_BAR, 0, WS_BAR_BYTES, stream) != hipSuccess) { fprintf(stderr, "kernel_launch: memset failed\n"); return; }
    Args a{};
    for (int i = 0; i < 15; ++i) a.in[i] = (const float*)d_in[i];
    a.out = (float*)d_out; a.ws = (unsigned char*)d_ws;
    void* args[] = {&a};
    hipError_t e = hipLaunchCooperativeKernel((const void*)fwd_megakernel, dim3(grid), dim3(NTHREADS), args, LDS_BYTES, stream);
    if (e != hipSuccess) fprintf(stderr, "cooperative launch failed: %s (grid %d)\n", hipGetErrorString(e), grid);
}
```

```cpp
#include <hip/hip_runtime.h>
#include <hip/hip_cooperative_groups.h>
#include <cstdio>
#include <cstdint>
namespace cg = cooperative_groups;
namespace pg8 {
#define PG8_LAS __attribute__((address_space(3)))
typedef unsigned short bf16_t;
typedef short bf16x8 __attribute__((ext_vector_type(8)));
typedef float f32x4 __attribute__((ext_vector_type(4)));
typedef unsigned u32x4 __attribute__((ext_vector_type(4)));
constexpr int BM = 256, BK = 64, HALF = 128, HTB = HALF * BK * 2  , STAGE_BYTES = 8 * HTB, NXCD = 8, WGM = 8;

__host__ __device__ __forceinline__ int lds_byte(int r, int c) { const int st = (r >> 4) * 2 + (c >> 5), rr = r & 15, cc = c & 31, ob = rr * 64 + cc * 2; return st * 1024 + (ob ^ (((ob >> 9) & 1) << 5)); }
__host__ __device__ __forceinline__ void stage_rc(int b, int& R, int& C) { const int st = b / 1024, sb = b % 1024, swz = sb ^ (((sb >> 9) & 1) << 5); R = (st >> 1) * 16 + swz / 64; C = (st & 1) * 32 + (swz % 64) / 2; }
__host__ __device__ __forceinline__ int perm32(int rho) { const int n = rho >> 4, i = rho & 15; return 8 * (i >> 2) + 4 * n + (i & 3); }

struct Unit { int pm, pn; };
struct Gemm { const bf16_t* A; const bf16_t* Bt; int M, N, K; };

struct StaticOrder {
    int nM, nN, nwg, G, c;
    __host__ __device__ void init(int M, int N, int G_, int c_) { nM = M / BM; nN = N / BM; nwg = nM * nN; G = G_; c = c_; }
    __host__ __device__ bool next(int i, Unit& u) const {
        const long L = (long)i * G + c; if (L >= nwg) return false;
        int wgid = (int)L; { const int q = nwg / NXCD, r = nwg % NXCD, xcd = wgid % NXCD, off = wgid / NXCD; wgid = (xcd < r ? xcd * (q + 1) : r * (q + 1) + (xcd - r) * q) + off; }
        const int nig = WGM * nN, gid = wgid / nig, fm = gid * WGM, gsz = (nM - fm) < WGM ? (nM - fm) : WGM;
        u.pm = fm + ((wgid % nig) % gsz); u.pn = (wgid % nig) / gsz; return true;
    }
    __device__ __forceinline__ void a_ready(const Unit&) const {}
    __device__ __forceinline__ void done(const Unit&) const {}
};

__device__ __forceinline__ unsigned cvt_pk_bf16(float lo, float hi) { unsigned r; asm volatile("v_cvt_pk_bf16_f32 %0, %1, %2" : "=v"(r) : "v"(lo), "v"(hi)); return r; }
typedef float f32x2 __attribute__((ext_vector_type(2)));
template <class Epi, class Sched, bool ALIGN_EPI = false, bool SP2 = false>
__device__ __forceinline__ void gemm_phase(PG8_LAS unsigned char* lds, const Gemm g, const Sched& S, const Epi& E) {
    int tid_ = threadIdx.x; asm volatile("" : "+v"(tid_));
    const int tid = tid_, wid = __builtin_amdgcn_readfirstlane(tid >> 6), lane = tid & 63, wr = wid >> 2, wc = wid & 3, fr = lane & 15, fq = lane >> 4;
    const int K = g.K, nt = K / BK;
    unsigned voffA[2], voffB[2];
#pragma unroll
    for (int i = 0; i < 2; ++i) { int R, C; stage_rc(tid * 16 + i * 8192, R, C); const int Rb = Epi::PERM ? ((R & ~31) + perm32(R & 31)) : R;
        voffA[i] = (unsigned)(R * K + C) * 2u; voffB[i] = (unsigned)(Rb * K + C) * 2u; }
    const size_t kstep = (size_t)(BK * 2);
    const size_t hstep = (size_t)HALF * K * 2;
    const size_t tstep = 2 * hstep;
    const unsigned ldsw = (unsigned)wid * 1024u;
    const int aoff = lds_byte(wr * 64 + fr, fq * 8), boff = lds_byte(wc * 32 + fr, fq * 8);
#define PG8_SA(b, h) (((b) * 2 + (h)) * HTB)
#define PG8_SB(b, h) ((4 + (b) * 2 + (h)) * HTB)
#define PG8_STAGE(bufoff, gbase, voff) do { _Pragma("unroll") for (int _i = 0; _i < 2; ++_i) \
        __builtin_amdgcn_global_load_lds((const unsigned*)((const char*)(gbase) + (voff)[_i]), (PG8_LAS unsigned*)(lds + (bufoff) + ldsw + _i * 8192), 16, 0, 0); } while (0)
#define PG8_LDA(dst, b, h) do { _Pragma("unroll") for (int m = 0; m < 4; ++m) _Pragma("unroll") for (int k = 0; k < 2; ++k) dst[m][k] = *(const PG8_LAS bf16x8*)(lds + PG8_SA(b, h) + aoff + m * 2048 + k * 1024); } while (0)
#define PG8_LDB(dst, b, h) do { _Pragma("unroll") for (int n = 0; n < 2; ++n) _Pragma("unroll") for (int k = 0; k < 2; ++k) dst[n][k] = *(const PG8_LAS bf16x8*)(lds + PG8_SB(b, h) + boff + n * 2048 + k * 1024); } while (0)
#define PG8_MMA(ai, bj, At, Bt) do { __builtin_amdgcn_s_setprio(1); _Pragma("unroll") for (int m = 0; m < 4; ++m) _Pragma("unroll") for (int n = 0; n < 2; ++n) _Pragma("unroll") for (int k = 0; k < 2; ++k) \
        acc[ai][bj][m][n] = __builtin_amdgcn_mfma_f32_16x16x32_bf16(Bt[n][k], At[m][k], acc[ai][bj][m][n], 0, 0, 0); __builtin_amdgcn_s_setprio(0); } while (0)
#define PG8_WAIT_V(n) asm volatile("s_waitcnt vmcnt(" #n ")" ::: "memory")
#define PG8_WAIT_L(n) asm volatile("s_waitcnt lgkmcnt(" #n ")" ::: "memory")
#define PG8_BAR __builtin_amdgcn_s_barrier()
#define PG8_SCHED __builtin_amdgcn_sched_barrier(0)
    Unit cur, nxt; int ui = 0;
    if (!S.next(0, cur)) return;
    f32x4 acc[2][2][4][2];
#pragma unroll
    for (int a = 0; a < 2; ++a)
#pragma unroll
        for (int b = 0; b < 2; ++b)
#pragma unroll
            for (int m = 0; m < 4; ++m)
#pragma unroll
                for (int n = 0; n < 2; ++n) acc[a][b][m][n] = (f32x4){0.f, 0.f, 0.f, 0.f};
    bf16x8 At[4][2], B0[2][2], B1[2][2];
    const char* cA = (const char*)g.A + (size_t)cur.pm * tstep; const char* cB = (const char*)g.Bt + (size_t)cur.pn * tstep;
    S.a_ready(cur);
    if constexpr (SP2) {
        PG8_STAGE(PG8_SB(0, 0), cB, voffB); PG8_STAGE(PG8_SB(0, 1), cB + hstep, voffB); PG8_STAGE(PG8_SA(0, 0), cA, voffA); PG8_STAGE(PG8_SA(0, 1), cA + hstep, voffA);
        if (wr == 1) PG8_BAR;
        PG8_WAIT_V(2); PG8_BAR;
        PG8_STAGE(PG8_SB(1, 0), cB + kstep, voffB); PG8_STAGE(PG8_SA(1, 0), cA + kstep, voffA); PG8_STAGE(PG8_SB(1, 1), cB + hstep + kstep, voffB);
        PG8_WAIT_V(6); PG8_BAR;
    } else {
        PG8_STAGE(PG8_SB(0, 0), cB, voffB); PG8_STAGE(PG8_SA(0, 0), cA, voffA); PG8_STAGE(PG8_SB(0, 1), cB + hstep, voffB); PG8_STAGE(PG8_SA(0, 1), cA + hstep, voffA);
        if (wr == 1) PG8_BAR;
        PG8_WAIT_V(4); PG8_BAR;
        PG8_STAGE(PG8_SB(1, 0), cB + kstep, voffB); PG8_STAGE(PG8_SA(1, 0), cA + kstep, voffA); PG8_STAGE(PG8_SB(1, 1), cB + hstep + kstep, voffB);
        PG8_WAIT_V(6); PG8_BAR;
    }
    for (;;) {
        const bool has_next = S.next(ui + 1, nxt);
        const char* nA = has_next ? (const char*)g.A + (size_t)nxt.pm * tstep : cA; const char* nB = has_next ? (const char*)g.Bt + (size_t)nxt.pn * tstep : cB;
        for (int t = 0; t < nt; t += 2) {
            const bool last = (t == nt - 2);
            const char* a1 = cA + (size_t)(t + 1) * kstep;
            const char* a2 = last ? nA : cA + (size_t)(t + 2) * kstep; const char* b2 = last ? nB : cB + (size_t)(t + 2) * kstep;
            const char* a3 = a2 + kstep; const char* b3 = b2 + kstep;
            if (last && has_next) S.a_ready(nxt);
            if constexpr (SP2) {
            PG8_LDB(B0, 0, 0); PG8_LDB(B1, 0, 1); PG8_SCHED; PG8_LDA(At, 0, 0); PG8_STAGE(PG8_SA(1, 1), a1 + hstep, voffA);
            PG8_WAIT_V(8); PG8_WAIT_L(0); PG8_BAR; PG8_MMA(0, 0, At, B0); PG8_MMA(0, 1, At, B1); PG8_BAR; PG8_SCHED;
            PG8_LDA(At, 0, 1); PG8_STAGE(PG8_SB(0, 0), b2, voffB); PG8_STAGE(PG8_SB(0, 1), b2 + hstep, voffB); PG8_STAGE(PG8_SA(0, 0), a2, voffA);
            PG8_WAIT_V(8); PG8_WAIT_L(0); PG8_BAR; PG8_MMA(1, 0, At, B0); PG8_MMA(1, 1, At, B1); PG8_BAR; PG8_SCHED;
            PG8_LDB(B0, 1, 0); PG8_LDB(B1, 1, 1); PG8_SCHED; PG8_LDA(At, 1, 0); PG8_STAGE(PG8_SA(0, 1), a2 + hstep, voffA);
            PG8_WAIT_V(8); PG8_WAIT_L(0); PG8_BAR; PG8_MMA(0, 0, At, B0); PG8_MMA(0, 1, At, B1); PG8_BAR; PG8_SCHED;
            PG8_LDA(At, 1, 1); PG8_STAGE(PG8_SB(1, 0), b3, voffB); PG8_STAGE(PG8_SB(1, 1), b3 + hstep, voffB); PG8_STAGE(PG8_SA(1, 0), a3, voffA);
            PG8_WAIT_V(8); PG8_WAIT_L(0); PG8_BAR; PG8_MMA(1, 0, At, B0); PG8_MMA(1, 1, At, B1); PG8_BAR; PG8_SCHED;
            } else {
            PG8_LDB(B0, 0, 0); PG8_SCHED; PG8_LDA(At, 0, 0); PG8_STAGE(PG8_SA(1, 1), a1 + hstep, voffA);
            PG8_WAIT_L(8); PG8_BAR; PG8_WAIT_L(0); PG8_MMA(0, 0, At, B0); PG8_BAR; PG8_SCHED;
            PG8_LDB(B1, 0, 1); PG8_STAGE(PG8_SB(0, 0), b2, voffB);
            PG8_BAR; PG8_WAIT_L(0); PG8_MMA(0, 1, At, B1); PG8_BAR;
            PG8_LDA(At, 0, 1); PG8_STAGE(PG8_SA(0, 0), a2, voffA);
            PG8_BAR; PG8_WAIT_L(0); PG8_MMA(1, 0, At, B0); PG8_BAR; PG8_SCHED;
            PG8_STAGE(PG8_SB(0, 1), b2 + hstep, voffB);
            PG8_WAIT_V(6); PG8_BAR; PG8_MMA(1, 1, At, B1); PG8_BAR;
            PG8_LDB(B0, 1, 0); PG8_SCHED; PG8_LDA(At, 1, 0); PG8_STAGE(PG8_SA(0, 1), a2 + hstep, voffA);
            PG8_WAIT_L(8); PG8_BAR; PG8_WAIT_L(0); PG8_MMA(0, 0, At, B0); PG8_BAR; PG8_SCHED;
            PG8_LDB(B1, 1, 1); PG8_STAGE(PG8_SB(1, 0), b3, voffB);
            PG8_BAR; PG8_WAIT_L(0); PG8_MMA(0, 1, At, B1); PG8_BAR;
            PG8_LDA(At, 1, 1); PG8_STAGE(PG8_SA(1, 0), a3, voffA);
            PG8_BAR; PG8_WAIT_L(0); PG8_MMA(1, 0, At, B0); PG8_BAR; PG8_SCHED;
            PG8_STAGE(PG8_SB(1, 1), b3 + hstep, voffB);
            PG8_WAIT_V(6); PG8_BAR; PG8_MMA(1, 1, At, B1); PG8_BAR;
            }
        }
        if constexpr (ALIGN_EPI) { if (wr == 0) PG8_BAR; }
        if constexpr (!Epi::AFTER_DRAIN) { E(acc, cur, wr, wc, fr, fq); S.done(cur); }
        if (!has_next) break;
#pragma unroll
        for (int a = 0; a < 2; ++a)
#pragma unroll
            for (int b = 0; b < 2; ++b)
#pragma unroll
                for (int m = 0; m < 4; ++m)
#pragma unroll
                    for (int n = 0; n < 2; ++n) acc[a][b][m][n] = (f32x4){0.f, 0.f, 0.f, 0.f};
        cur = nxt; cA = nA; cB = nB; ++ui;
        if constexpr (ALIGN_EPI) { if (wr == 1) PG8_BAR; }
    }
    PG8_WAIT_V(0);
    if constexpr (!ALIGN_EPI) { if (wr == 0) PG8_BAR; }
    PG8_BAR;
    if constexpr (Epi::AFTER_DRAIN) { E.fused(acc, cur, wr, wc, fr, fq, lds, wid, lane); S.done(cur); }
#undef PG8_SA
#undef PG8_SB
#undef PG8_STAGE
#undef PG8_LDA
#undef PG8_LDB
#undef PG8_MMA
#undef PG8_WAIT_V
#undef PG8_WAIT_L
#undef PG8_BAR
#undef PG8_SCHED
}
}

#define LAS __attribute__((address_space(3)))
typedef unsigned short bf16_t;
typedef short bf16x8 __attribute__((ext_vector_type(8)));
typedef float f32x4 __attribute__((ext_vector_type(4)));
typedef float f32x16 __attribute__((ext_vector_type(16)));
typedef unsigned u32x2 __attribute__((ext_vector_type(2)));
typedef unsigned u32x4 __attribute__((ext_vector_type(4)));

#define XB_TMO      128
#define XB_XCNT(j)  (256  + 64 * (j))
#define XB_XSUB(j)  (1280 + 64 * (j))
#define XB_XGEN(j)  (2304 + 64 * (j))
#define XB_TOP      3328
#define XB_TOPGEN   3392
#define XCD_BAR_WORDS 3456
#define XB_SPIN_CAP (1u << 18)

__device__ __forceinline__ unsigned xb_ld(unsigned* p)              { return __hip_atomic_load(p, __ATOMIC_RELAXED, __HIP_MEMORY_SCOPE_AGENT); }
__device__ __forceinline__ unsigned xb_add(unsigned* p, unsigned v) { return __hip_atomic_fetch_add(p, v, __ATOMIC_RELAXED, __HIP_MEMORY_SCOPE_AGENT); }
__device__ __forceinline__ unsigned xb_xcc_id() { return (unsigned)__builtin_amdgcn_s_getreg((3 << 11) | 20) & 0xFu; }
#define XB_SPIN(cond, bar) do { unsigned _sp = 0; while (cond) { __builtin_amdgcn_s_sleep(1); \
    if ((++_sp & 255u) == 0u) { if (xb_ld(&(bar)[XB_TMO])) break; if (_sp > XB_SPIN_CAP) { atomicAdd(&(bar)[XB_TMO], 1u); break; } } } } while (0)

struct XcdBarrier {
    unsigned* bar; unsigned x;
    volatile LAS unsigned* st;
};

__device__ __forceinline__ XcdBarrier xcd_barrier_post(unsigned* bar, volatile LAS unsigned* st) {
    XcdBarrier b; b.bar = bar; b.x = xb_xcc_id(); b.st = st;
    if (threadIdx.x == 0) (void)xb_add(&bar[XB_XCNT(b.x)], 1u);
    return b;
}
__device__ __forceinline__ void xcd_barrier_complete(unsigned* bar, unsigned x, unsigned& nloc, unsigned& nx) {
    const unsigned G = gridDim.x * gridDim.y * gridDim.z;
    unsigned sum, cnt, mine, sp = 0u;
    for (;;) {
        sum = 0u; cnt = 0u; mine = 0u;
#pragma unroll
        for (unsigned j = 0; j < 16; ++j) { const unsigned c = xb_ld(&bar[XB_XCNT(j)]); sum += c; cnt += (c > 0u) ? 1u : 0u; mine = (j == x) ? c : mine; }
        if (sum == G) break;
        __builtin_amdgcn_s_sleep(1);
        if ((++sp & 255u) == 0u) { if (xb_ld(&bar[XB_TMO])) break; if (sp > XB_SPIN_CAP) { atomicAdd(&bar[XB_TMO], 1u); break; } }
    }
    nloc = mine > 0u ? mine : 1u; nx = cnt > 0u ? cnt : 1u;
}

__device__ __forceinline__ void xcd_barrier(const XcdBarrier& b) {
    asm volatile("s_waitcnt vmcnt(0)" ::: "memory");
    __syncthreads();
    if (threadIdx.x == 0) {
        unsigned* bar = b.bar;
        __builtin_amdgcn_s_waitcnt(0);
        unsigned nloc = b.st[0], nx = b.st[1];
        if (nloc == 0u) { xcd_barrier_complete(bar, b.x, nloc, nx); b.st[0] = nloc; b.st[1] = nx; }
        const unsigned old = xb_add(&bar[XB_XSUB(b.x)], 1u);
        const unsigned gen = old / nloc;
        if (old + 1u == (gen + 1u) * nloc) {
            __builtin_amdgcn_fence(__ATOMIC_RELEASE, "agent");
            asm volatile("s_waitcnt vmcnt(0)" ::: "memory");
            const unsigned og = xb_add(&bar[XB_TOP], 1u);
            const unsigned tg = og / nx;
            if (og + 1u == (tg + 1u) * nx) xb_add(&bar[XB_TOPGEN], 1u);
            else XB_SPIN(xb_ld(&bar[XB_TOPGEN]) == tg, bar);
            __builtin_amdgcn_fence(__ATOMIC_ACQUIRE, "agent");
            xb_add(&bar[XB_XGEN(b.x)], 1u);
            asm volatile("s_waitcnt vmcnt(0)" ::: "memory");
        } else {
            XB_SPIN(xb_ld(&bar[XB_XGEN(b.x)]) == gen, bar);
            __builtin_amdgcn_fence(__ATOMIC_ACQUIRE, "agent");
            asm volatile("s_waitcnt vmcnt(0)" ::: "memory");
        }
    }
    __syncthreads();
}

constexpr int SEQ = 8192, NBATCH = 2, M = NBATCH * SEQ, DM = 1024, FF = 4096;
constexpr int NIN = 4352;
constexpr float EPS = 1e-6f;
constexpr float LOG2E = 1.4426950408889634f;
constexpr float C_A = 0.125f * LOG2E;
constexpr float C_B = 0.10206207261596575f * LOG2E;
constexpr size_t MiB = 1u << 20;
constexpr size_t WS_BAR = 512 * 1024, WS_BAR_BYTES = 16384;
constexpr size_t WS_ROWSS_Q = 0, WS_ROWSS_KV = 65536, WS_ROWSS2 = 131072, WS_KMEAN = 196608, WS_CNT = 327680, WS_CTL_END = 329728;
constexpr size_t WS_PART_ML = 116 * MiB  , WS_PART_O = 204 * MiB, WS_LIST = 252 * MiB;
constexpr size_t WS_WIN = 1 * MiB, WS_WQUP = 10 * MiB, WS_WKVUP = 11 * MiB, WS_WOA = 12 * MiB, WS_WOB = 13 * MiB, WS_WOUT = 14 * MiB, WS_WFF1 = 16 * MiB, WS_WFF2 = 24 * MiB;
constexpr size_t WS_ROPE64 = 32 * MiB, WS_ROPE32 = 34 * MiB;
constexpr size_t WS_XN = 36 * MiB, WS_OA = 36 * MiB, WS_OB = 52 * MiB, WS_X1B = 36 * MiB;
constexpr size_t WS_QA = 68 * MiB, WS_KA = 84 * MiB, WS_VA = 100 * MiB, WS_CQ = 116 * MiB, WS_CKV = 128 * MiB, WS_QB = 138 * MiB, WS_KB = 162 * MiB, WS_VB = 186 * MiB;
constexpr size_t WS_Z = 68 * MiB, WS_U = 68 * MiB, WS_END = 256 * MiB;
constexpr int LDS_BYTES = 147456;
constexpr int NTHREADS = 512;

typedef float f32x2_t __attribute__((ext_vector_type(2))); typedef __bf16 bf16x2_t __attribute__((ext_vector_type(2)));
__device__ __forceinline__ unsigned cvtpk(float lo, float hi) { f32x2_t v = {lo, hi}; bf16x2_t b = __builtin_convertvector(v, bf16x2_t); return __builtin_bit_cast(unsigned, b); }
__device__ __forceinline__ void st4(bf16_t* p, f32x4 v) { u32x2 w; w.x = cvtpk(v[0], v[1]); w.y = cvtpk(v[2], v[3]); *(u32x2*)p = w; }
__device__ __forceinline__ float bf2f(unsigned short s) { return __uint_as_float(((unsigned)s) << 16); }
__device__ __forceinline__ f32x4 ld4bf(const bf16_t* p) { const u32x2 w = *(const u32x2*)p; return (f32x4){__uint_as_float(w.x << 16), __uint_as_float(w.x & 0xffff0000u), __uint_as_float(w.y << 16), __uint_as_float(w.y & 0xffff0000u)}; }
__device__ __forceinline__ float wave_sum(float v) {
#pragma unroll
    for (int o = 1; o < 64; o <<= 1) v += __shfl_xor(v, o);
    return v;
}

#define EPI_ROWS(ai, m) for (int ai = 0; ai < 2; ++ai) _Pragma("unroll") for (int m = 0; m < 4; ++m)

struct EpiProj {
    static constexpr bool PERM = false, AFTER_DRAIN = false;
    bf16_t *QA, *KA, *VA, *CQ, *CKV, *KB, *G; float *ROWSS_Q, *ROWSS_KV, *KMEAN; const float *ROPE64, *ROPE32, *b_gate; float asc;
    __device__ __forceinline__ void operator()(const f32x4 (&acc)[2][2][4][2], const pg8::Unit& u, int wr, int wc, int fr, int fq) const {
        const int pn = u.pn; const int row0 = u.pm * 256 + wr * 64 + fr; const int cl = wc * 32 + 4 * fq;
        if (pn < 4) {
            bf16_t* dst = pn < 2 ? QA : KA; const int cbase = (pn & 1) * 256; const float sc = pn < 2 ? C_A : 1.f; const int fi = 16 * (wc & 1) + 4 * fq;
            f32x4 ks[2][2];
#pragma unroll
            for (int bj = 0; bj < 2; ++bj) { ks[bj][0] = (f32x4){0.f, 0.f, 0.f, 0.f}; ks[bj][1] = (f32x4){0.f, 0.f, 0.f, 0.f}; }
#pragma unroll
            EPI_ROWS(ai, m) {
                const int row = row0 + 128 * ai + 16 * m; const int pos = row & (SEQ - 1);
                const f32x4* rp = (const f32x4*)(ROPE64 + ((size_t)pos * 32 + fi) * 2); const f32x4 r01 = rp[0], r23 = rp[1];
                const f32x4 c = (f32x4){r01[0], r01[2], r23[0], r23[2]}, s = (f32x4){r01[1], r01[3], r23[1], r23[3]};
#pragma unroll
                for (int bj = 0; bj < 2; ++bj) {
                    const f32x4 x1 = acc[ai][bj][m][0], x2 = acc[ai][bj][m][1];
                    const f32x4 o1 = x1 * c - x2 * s, o2 = x2 * c + x1 * s;
                    ks[bj][0] += o1; ks[bj][1] += o2;
                    bf16_t* p = dst + (size_t)row * 512 + cbase + 128 * bj + cl;
                    st4(p, o1 * sc); st4(p + 16, o2 * sc);
                }
            }
            if (pn >= 2) {
#pragma unroll
                for (int bj = 0; bj < 2; ++bj)
#pragma unroll
                    for (int n = 0; n < 2; ++n)
#pragma unroll
                        for (int j = 0; j < 4; ++j) { float v = ks[bj][n][j]; v += __shfl_xor(v, 1); v += __shfl_xor(v, 2); v += __shfl_xor(v, 4); v += __shfl_xor(v, 8);
                            if (fr == 0) unsafeAtomicAdd(KMEAN + (size_t)u.pm * 512 + cbase + 128 * bj + cl + 16 * n + j, v * (asc * (1.f / 256.f))); }
            }
        } else if (pn < 6) {
            const int cbase = (pn - 4) * 256;
#pragma unroll
            EPI_ROWS(ai, m) { const int row = row0 + 128 * ai + 16 * m;
#pragma unroll
                for (int bj = 0; bj < 2; ++bj)
#pragma unroll
                    for (int n = 0; n < 2; ++n) st4(VA + (size_t)row * 512 + cbase + 128 * bj + cl + 16 * n, acc[ai][bj][m][n]); }
        } else if (pn < 9) {
#pragma unroll
            EPI_ROWS(ai, m) { const int row = row0 + 128 * ai + 16 * m; float sq = 0.f, skv = 0.f;
#pragma unroll
                for (int bj = 0; bj < 2; ++bj) {
                    const f32x4 v0 = acc[ai][bj][m][0], v1 = acc[ai][bj][m][1];
                    const float ss = (v0[0] * v0[0] + v0[1] * v0[1]) + (v0[2] * v0[2] + v0[3] * v0[3]) + (v1[0] * v1[0] + v1[1] * v1[1]) + (v1[2] * v1[2] + v1[3] * v1[3]);
                    const int sel = (pn - 6) * 2 + bj;
                    if (sel < 3) { sq += ss; bf16_t* p = CQ + (size_t)row * 384 + 128 * sel + cl; st4(p, v0); st4(p + 16, v1); }
                    else if (sel < 5) { skv += ss; bf16_t* p = CKV + (size_t)row * 256 + 128 * (sel - 3) + cl; st4(p, v0); st4(p + 16, v1); }
                    else if (wc == 0) {
                        const int pos = row & (SEQ - 1);
                        const f32x4* rp = (const f32x4*)(ROPE32 + ((size_t)pos * 16 + 4 * fq) * 2); const f32x4 r01 = rp[0], r23 = rp[1];
                        const f32x4 c = (f32x4){r01[0], r01[2], r23[0], r23[2]}, s = (f32x4){r01[1], r01[3], r23[1], r23[3]};
                        const f32x4 o1 = v0 * c - v1 * s, o2 = v1 * c + v0 * s;
#pragma unroll
                        for (int h = 0; h < 8; ++h) { bf16_t* p = KB + (size_t)row * 768 + 96 * h + 64 + 4 * fq; st4(p, o1); st4(p + 16, o2); }
                    }
                }
                if (pn < 8) { sq += __shfl_xor(sq, 16); sq += __shfl_xor(sq, 32); if (fq == 0) unsafeAtomicAdd(ROWSS_Q + row, sq * asc); }
                if (pn > 6) { skv += __shfl_xor(skv, 16); skv += __shfl_xor(skv, 32); if (fq == 0) unsafeAtomicAdd(ROWSS_KV + row, skv * asc); }
            }
        } else {
            const int gbase = (pn - 9) * 256;
#pragma unroll
            for (int bj = 0; bj < 2; ++bj)
#pragma unroll
                for (int n = 0; n < 2; ++n) {
                    const int gc = gbase + 128 * bj + cl + 16 * n; const f32x4 bv = *(const f32x4*)(b_gate + gc);
                    bf16_t* dst = G + (size_t)(gc >> 10) * ((size_t)M * 1024) + (gc & 1023);
#pragma unroll
                    EPI_ROWS(ai, m) { const int row = row0 + 128 * ai + 16 * m; f32x4 v = acc[ai][bj][m][n] + bv;
#pragma unroll
                        for (int j = 0; j < 4; ++j) v[j] = __builtin_amdgcn_rcpf(1.f + __builtin_amdgcn_exp2f(-LOG2E * v[j]));
                        st4(dst + (size_t)row * 1024, v); }
                }
        }
    }
};
struct EpiQup {
    static constexpr bool PERM = false, AFTER_DRAIN = false;
    bf16_t* QB; const float *ROWSS_Q, *ROPE32;
    __device__ __forceinline__ void operator()(const f32x4 (&acc)[2][2][4][2], const pg8::Unit& u, int wr, int wc, int fr, int fq) const {
        const int row0 = u.pm * 256 + wr * 64 + fr;
#pragma unroll
        EPI_ROWS(ai, m) { const int row = row0 + 128 * ai + 16 * m; const float rs = rsqrtf(ROWSS_Q[row] * (1.f / 384.f) + EPS) * C_B; const int pos = row & (SEQ - 1);
#pragma unroll
            for (int bj = 0; bj < 2; ++bj) {
                const int grp = 8 * u.pn + 4 * bj + wc; const int part = grp % 3;
                f32x4 v0 = acc[ai][bj][m][0] * rs, v1 = acc[ai][bj][m][1] * rs;
                if (part == 2) {
                    const f32x4* rp = (const f32x4*)(ROPE32 + ((size_t)pos * 16 + 4 * fq) * 2); const f32x4 r01 = rp[0], r23 = rp[1];
                    const f32x4 c = (f32x4){r01[0], r01[2], r23[0], r23[2]}, s = (f32x4){r01[1], r01[3], r23[1], r23[3]};
                    const f32x4 o1 = v0 * c - v1 * s, o2 = v1 * c + v0 * s; v0 = o1; v1 = o2;
                }
                bf16_t* p = QB + (size_t)row * 768 + 32 * grp + 4 * fq; st4(p, v0); st4(p + 16, v1);
            } }
    }
};
struct EpiKVup {
    static constexpr bool PERM = false, AFTER_DRAIN = false;
    bf16_t *KB, *VB; const float* ROWSS_KV;
    __device__ __forceinline__ void operator()(const f32x4 (&acc)[2][2][4][2], const pg8::Unit& u, int wr, int wc, int fr, int fq) const {
        const int row0 = u.pm * 256 + wr * 64 + fr;
#pragma unroll
        EPI_ROWS(ai, m) { const int row = row0 + 128 * ai + 16 * m; const float rs = rsqrtf(ROWSS_KV[row] * (1.f / 256.f) + EPS);
#pragma unroll
            for (int bj = 0; bj < 2; ++bj) { const int head = 2 * u.pn + bj;
                bf16_t* p = (wc < 2) ? KB + (size_t)row * 768 + 96 * head + 32 * wc + 4 * fq : VB + (size_t)row * 512 + 64 * head + 32 * (wc - 2) + 4 * fq;
                st4(p, acc[ai][bj][m][0] * rs); st4(p + 16, acc[ai][bj][m][1] * rs); } }
    }
};
template <bool ADD> struct EpiGate {
    static constexpr bool PERM = false, AFTER_DRAIN = false;
    bf16_t* Z; const bf16_t* Gt;
    __device__ __forceinline__ void operator()(const f32x4 (&acc)[2][2][4][2], const pg8::Unit& u, int wr, int wc, int fr, int fq) const {
        const int row0 = u.pm * 256 + wr * 64 + fr; const int col0 = u.pn * 256 + wc * 32 + 4 * fq;
#pragma unroll
        EPI_ROWS(ai, m) { const size_t ro = (size_t)(row0 + 128 * ai + 16 * m) * 1024 + col0;
#pragma unroll
            for (int bj = 0; bj < 2; ++bj)
#pragma unroll
                for (int n = 0; n < 2; ++n) { const size_t o = ro + 128 * bj + 16 * n; f32x4 v = acc[ai][bj][m][n] * ld4bf(Gt + o); if (ADD) v += ld4bf(Z + o); st4(Z + o, v); } }
    }
};
struct EpiOut {
    static constexpr bool PERM = false, AFTER_DRAIN = false;
    const float* X; float* X1; bf16_t* X1B; float* ROWSS2; float asc;
    __device__ __forceinline__ void operator()(const f32x4 (&acc)[2][2][4][2], const pg8::Unit& u, int wr, int wc, int fr, int fq) const {
        const int row0 = u.pm * 256 + wr * 64 + fr; const int col0 = u.pn * 256 + wc * 32 + 4 * fq;
#pragma unroll
        EPI_ROWS(ai, m) { const int row = row0 + 128 * ai + 16 * m; const size_t ro = (size_t)row * 1024 + col0; float ss = 0.f;
#pragma unroll
            for (int bj = 0; bj < 2; ++bj)
#pragma unroll
                for (int n = 0; n < 2; ++n) { const size_t o = ro + 128 * bj + 16 * n; const f32x4 v = acc[ai][bj][m][n] + *(const f32x4*)(X + o);
                    ss += (v[0] * v[0] + v[1] * v[1]) + (v[2] * v[2] + v[3] * v[3]); st4(X1B + o, v); }
            ss += __shfl_xor(ss, 16); ss += __shfl_xor(ss, 32); if (fq == 0) unsafeAtomicAdd(ROWSS2 + row, ss * asc); }
    }
};
struct EpiFF1 {
    static constexpr bool PERM = false, AFTER_DRAIN = false;
    bf16_t* U; const float* ROWSS2;
    __device__ __forceinline__ void operator()(const f32x4 (&acc)[2][2][4][2], const pg8::Unit& u, int wr, int wc, int fr, int fq) const {
        const int row0 = u.pm * 256 + wr * 64 + fr; const int col0 = u.pn * 256 + wc * 32 + 4 * fq;
#pragma unroll
        EPI_ROWS(ai, m) { const int row = row0 + 128 * ai + 16 * m; const float r2 = 1.f / (ROWSS2[row] * (1.f / 1024.f) + EPS);
#pragma unroll
            for (int bj = 0; bj < 2; ++bj)
#pragma unroll
                for (int n = 0; n < 2; ++n) { f32x4 v = acc[ai][bj][m][n];
#pragma unroll
                    for (int j = 0; j < 4; ++j) { const float t = fmaxf(v[j], 0.f); v[j] = t * t * r2; }
                    st4(U + (size_t)row * FF + col0 + 128 * bj + 16 * n, v); } }
    }
};
struct EpiFF2 {
    static constexpr bool PERM = false, AFTER_DRAIN = false;
    float* X2; const bf16_t* X1B;
    __device__ __forceinline__ void operator()(const f32x4 (&acc)[2][2][4][2], const pg8::Unit& u, int wr, int wc, int fr, int fq) const {
        const int row0 = u.pm * 256 + wr * 64 + fr; const int col0 = u.pn * 256 + wc * 32 + 4 * fq;
#pragma unroll
        EPI_ROWS(ai, m) { const size_t ro = (size_t)(row0 + 128 * ai + 16 * m) * 1024 + col0;
#pragma unroll
            for (int bj = 0; bj < 2; ++bj)
#pragma unroll
                for (int n = 0; n < 2; ++n) { const size_t o = ro + 128 * bj + 16 * n; *(f32x4*)(X2 + o) = ld4bf(X1B + o) + acc[ai][bj][m][n]; } }
    }
};

__device__ __forceinline__ int crow(int r, int hi) { return (r & 3) + 8 * (r >> 2) + 4 * hi; }
struct MobaAux { const unsigned short* list; int cnt; int chunk; bf16_t* part_o; float* part_ml; };
template <int DQK, int MODE>
__device__ __forceinline__ void attn_unit(int b, int h, int qb, const bf16_t* __restrict__ Qg, const bf16_t* __restrict__ Kg, const bf16_t* __restrict__ Vg, bf16_t* __restrict__ Og,
                                          const MobaAux ax, LAS unsigned char* lds) {
    constexpr int LDQ = 8 * DQK, ND = DQK / 16, KP = DQK * 2 + 16, VP = 144, KBYTES = 64 * KP, VBYTES = 64 * VP, VOFF = 2 * KBYTES, CTLOFF = 2 * KBYTES + 2 * VBYTES;
    constexpr int KCH = DQK / 8;
    constexpr bool MOBA = false;
    LAS int* tl = (LAS int*)(lds + CTLOFF + 64);
    int tid_ = threadIdx.x; asm volatile("" : "+v"(tid_));
    const int tid = tid_, lane = tid & 63, wid = __builtin_amdgcn_readfirstlane(tid >> 6), r32 = lane & 31, hi = lane >> 5;
    const size_t rowbase = (size_t)b * SEQ; const int q0 = qb * 256;
    int qrow_idx = q0 + wid * 32 + r32, slot = 0; bool valid = true;
    if constexpr (MODE == 1) { const int idx = ax.chunk * 256 + wid * 32 + r32; valid = idx < ax.cnt; const unsigned e_ = ax.list[valid ? idx : ax.cnt - 1]; qrow_idx = (int)(e_ & 8191u); slot = (int)(e_ >> 13); }
    bf16x8 qf[ND];
    { const bf16_t* qrow = Qg + (rowbase + qrow_idx) * LDQ + h * DQK + 8 * hi;
#pragma unroll
      for (int d0 = 0; d0 < ND; ++d0) qf[d0] = *(const bf16x8*)(qrow + 16 * d0); }
    const unsigned selmask = 0u;
    const unsigned um = (MODE != 0 || qb == 0) ? 0u : (0xffffffffu >> (32 - qb));
    const int tile0 = (MODE == 1) ? qb * 256 : q0;
    const int nblk = __builtin_popcount(um); const int nt = 4 * (nblk + 1);
    if (tid < 32) { if ((um >> tid) & 1u) { const int idx = __builtin_popcount(um & ((1u << tid) - 1u));
#pragma unroll
            for (int s = 0; s < 4; ++s) tl[4 * idx + s] = 256 * tid + 64 * s; } }
    else if (tid == 32) {
#pragma unroll
        for (int s = 0; s < 4; ++s) tl[4 * nblk + s] = tile0 + 64 * s; }
    __syncthreads();
    const int kr0 = (KCH == 8) ? (tid >> 3) : (tid / 12), kc0 = (KCH == 8) ? (tid & 7) : (tid % 12);
    const int kr1 = (tid + 512) / 12, kc1 = (tid + 512) % 12; const bool has2 = (KCH == 12) && (tid < 256); const int kr1c = has2 ? kr1 : kr0;
    const bf16_t* Kh = Kg + rowbase * LDQ + h * DQK; const bf16_t* Vh = Vg + rowbase * 512 + h * 64;
    const int vkv = tid & 63, vdg = tid >> 6;
    const int vpos = (vkv & ~15) | (((vkv >> 2) & 1) << 3) | (((vkv >> 3) & 1) << 2) | (vkv & 3);
    u32x4 kA0, kA1 = (u32x4){0u, 0u, 0u, 0u}, vA, kB0, kB1 = (u32x4){0u, 0u, 0u, 0u}, vB;
#define ATT_LOADK(K0, K1, kv0) do { K0 = *(const u32x4*)(Kh + (size_t)((kv0) + kr0) * LDQ + 8 * kc0); if constexpr (KCH == 12) K1 = *(const u32x4*)(Kh + (size_t)((kv0) + kr1c) * LDQ + 8 * kc1); } while (0)
#define ATT_LOADV(V_, kv0) do { V_ = *(const u32x4*)(Vh + (size_t)((kv0) + vkv) * 512 + 8 * vdg); } while (0)
#define ATT_STOREK(K0, K1, buf) do { LAS unsigned char* kb_ = lds + (buf) * KBYTES; *(LAS u32x4*)(kb_ + kr0 * KP + 16 * kc0) = K0; if (has2) *(LAS u32x4*)(kb_ + kr1 * KP + 16 * kc1) = K1; } while (0)
#define ATT_STOREV(V_, buf) do { LAS unsigned char* vb_ = lds + VOFF + (buf) * VBYTES + (8 * vdg) * VP + 2 * vpos; \
        *(LAS unsigned short*)(vb_ + 0 * VP) = (unsigned short)(V_.x & 0xffffu); *(LAS unsigned short*)(vb_ + 1 * VP) = (unsigned short)(V_.x >> 16); \
        *(LAS unsigned short*)(vb_ + 2 * VP) = (unsigned short)(V_.y & 0xffffu); *(LAS unsigned short*)(vb_ + 3 * VP) = (unsigned short)(V_.y >> 16); \
        *(LAS unsigned short*)(vb_ + 4 * VP) = (unsigned short)(V_.z & 0xffffu); *(LAS unsigned short*)(vb_ + 5 * VP) = (unsigned short)(V_.z >> 16); \
        *(LAS unsigned short*)(vb_ + 6 * VP) = (unsigned short)(V_.w & 0xffffu); *(LAS unsigned short*)(vb_ + 7 * VP) = (unsigned short)(V_.w >> 16); } while (0)
#define ATT_QK(S0, S1, kbuf) do { const LAS unsigned char* kb_ = lds + (kbuf) * KBYTES + r32 * KP + (8 * hi) * 2; \
        S0 = __builtin_amdgcn_mfma_f32_32x32x16_bf16(*(const LAS bf16x8*)(kb_), qf[0], cinit, 0, 0, 0); \
        S1 = __builtin_amdgcn_mfma_f32_32x32x16_bf16(*(const LAS bf16x8*)(kb_ + 32 * KP), qf[0], cinit, 0, 0, 0); \
        _Pragma("unroll") for (int d0 = 1; d0 < ND; ++d0) { \
            S0 = __builtin_amdgcn_mfma_f32_32x32x16_bf16(*(const LAS bf16x8*)(kb_ + 32 * d0), qf[d0], S0, 0, 0, 0); \
            S1 = __builtin_amdgcn_mfma_f32_32x32x16_bf16(*(const LAS bf16x8*)(kb_ + 32 * KP + 32 * d0), qf[d0], S1, 0, 0, 0); } } while (0)
    f32x16 o0, o1, cinit;
#pragma unroll
    for (int r = 0; r < 16; ++r) { o0[r] = 0.f; o1[r] = 0.f; cinit[r] = 0.f; }
    float lrun = 0.f, negm = 0.f; bool started = false; int curblk = -1;
#define ATT_CINIT(kvpos) do { if constexpr (MOBA) { const int blk_ = (kvpos) >> 8; if (blk_ != curblk) { curblk = blk_; const float cv_ = (blk_ == qb || ((selmask >> blk_) & 1u)) ? negm : -INFINITY; \
        _Pragma("unroll") for (int r = 0; r < 16; ++r) cinit[r] = cv_; } } } while (0)
    ATT_LOADK(kA0, kA1, tl[0]); ATT_LOADV(vA, tl[0]); ATT_STOREK(kA0, kA1, 0); ATT_STOREV(vA, 0);
    ATT_LOADK(kA0, kA1, tl[1]);
    __syncthreads();
    f32x16 s0, s1;
    ATT_CINIT(tl[0]);
    ATT_QK(s0, s1, 0);
    ATT_STOREK(kA0, kA1, 1);
    ATT_LOADK(kB0, kB1, tl[2]); ATT_LOADV(vB, tl[1]);
    __syncthreads();
    auto body = [&](const int it, u32x4& LK0, u32x4& LK1, u32x4& LV, const u32x4& SK0, const u32x4& SK1, const u32x4& SV) __attribute__((always_inline)) {
        const int kv0 = tl[it]; const bool diag = (MODE == 1) ? false : ((kv0 >> 8) == qb);
        const bool n1 = (it + 1 < nt);
        { const int kvk = tl[(it + 3 < nt) ? it + 3 : nt - 1], kvv = tl[(it + 2 < nt) ? it + 2 : nt - 1]; ATT_LOADK(LK0, LK1, kvk); ATT_LOADV(LV, kvv); }
        if (diag) { const int qrel = 32 * wid + r32 - (kv0 - q0);
#pragma unroll
            for (int r = 0; r < 16; ++r) { const int kvr = crow(r, hi); if (kvr > qrel) s0[r] = -INFINITY; if (kvr + 32 > qrel) s1[r] = -INFINITY; } }
        float mxa = __builtin_fmaxf(__builtin_fmaxf(s0[0], s0[1]), s1[0]), mxb = __builtin_fmaxf(__builtin_fmaxf(s0[2], s0[3]), s1[1]);
        mxa = __builtin_fmaxf(__builtin_fmaxf(mxa, s1[2]), s1[3]);
#pragma unroll
        for (int r = 4; r < 16; r += 4) { mxa = __builtin_fmaxf(__builtin_fmaxf(mxa, s0[r]), s0[r + 1]); mxb = __builtin_fmaxf(__builtin_fmaxf(mxb, s0[r + 2]), s0[r + 3]);
            mxa = __builtin_fmaxf(__builtin_fmaxf(mxa, s1[r]), s1[r + 1]); mxb = __builtin_fmaxf(__builtin_fmaxf(mxb, s1[r + 2]), s1[r + 3]); }
        float mx = __builtin_fmaxf(mxa, mxb);
        { auto rr = __builtin_amdgcn_permlane32_swap(__float_as_uint(mx), __float_as_uint(mx), false, false); mx = __builtin_fmaxf(__uint_as_float(rr[0]), __uint_as_float(rr[1])); }
        const bool need = started ? (mx > 8.f) : (mx > -INFINITY);
        if (__any(need)) {
            const float dl = need ? mx : 0.f; started = started || need;
            negm -= dl;
#pragma unroll
            for (int r = 0; r < 16; ++r) { s0[r] -= dl; s1[r] -= dl; cinit[r] -= dl; }
            const float alpha = __builtin_amdgcn_exp2f(-dl); lrun *= alpha;
#pragma unroll
            for (int r = 0; r < 16; ++r) { o0[r] *= alpha; o1[r] *= alpha; }
        }
        f32x16 t0, t1;
        { const int kvn = n1 ? tl[it + 1] : kv0; ATT_CINIT(kvn); }
        ATT_QK(t0, t1, (it + 1) & 1);
#pragma unroll
        for (int r = 0; r < 16; ++r) { s0[r] = __builtin_amdgcn_exp2f(s0[r]); s1[r] = __builtin_amdgcn_exp2f(s1[r]); }
        float lsa = s0[0], lsb = s1[0];
#pragma unroll
        for (int r = 1; r < 16; ++r) { lsa += s0[r]; lsb += s1[r]; }
        lrun += lsa + lsb;
        const LAS unsigned char* vb = lds + VOFF + (it & 1) * VBYTES;
#pragma unroll
        for (int kt = 0; kt < 2; ++kt)
#pragma unroll
            for (int uu = 0; uu < 2; ++uu) {
                u32x4 pw;
                if (kt == 0) { pw.x = cvtpk(s0[8 * uu + 0], s0[8 * uu + 1]); pw.y = cvtpk(s0[8 * uu + 2], s0[8 * uu + 3]); pw.z = cvtpk(s0[8 * uu + 4], s0[8 * uu + 5]); pw.w = cvtpk(s0[8 * uu + 6], s0[8 * uu + 7]); }
                else         { pw.x = cvtpk(s1[8 * uu + 0], s1[8 * uu + 1]); pw.y = cvtpk(s1[8 * uu + 2], s1[8 * uu + 3]); pw.z = cvtpk(s1[8 * uu + 4], s1[8 * uu + 5]); pw.w = cvtpk(s1[8 * uu + 6], s1[8 * uu + 7]); }
                const bf16x8 pb = __builtin_bit_cast(bf16x8, pw);
                const int kvo = (32 * kt + 16 * uu + 8 * hi) * 2;
#pragma unroll
                for (int dt = 0; dt < 2; ++dt) {
                    const bf16x8 va = *(const LAS bf16x8*)(vb + (32 * dt + r32) * VP + kvo);
                    if (dt == 0) o0 = __builtin_amdgcn_mfma_f32_32x32x16_bf16(va, pb, o0, 0, 0, 0); else o1 = __builtin_amdgcn_mfma_f32_32x32x16_bf16(va, pb, o1, 0, 0, 0);
                }
            }
        ATT_STOREK(SK0, SK1, it & 1);
        ATT_STOREV(SV, (it + 1) & 1);
        __syncthreads();
        s0 = t0; s1 = t1;
    };
    for (int it = 0; it < nt; it += 2) { body(it, kA0, kA1, vA, kB0, kB1, vB); body(it + 1, kB0, kB1, vB, kA0, kA1, vA); }
#undef ATT_LOADK
#undef ATT_LOADV
#undef ATT_STOREK
#undef ATT_STOREV
#undef ATT_QK
#undef ATT_CINIT
    lrun += __shfl_xor(lrun, 32);
    if constexpr (MODE == 1) {
        const float inv = 1.f / lrun;
        if (valid) {
            const size_t pidx = ((size_t)(b * 8 + h) * SEQ + qrow_idx) * 3 + slot;
            bf16_t* po = ax.part_o + pidx * 64 + 4 * hi;
#pragma unroll
            for (int g = 0; g < 4; ++g) {
                st4(po + 8 * g, (f32x4){o0[4 * g] * inv, o0[4 * g + 1] * inv, o0[4 * g + 2] * inv, o0[4 * g + 3] * inv});
                st4(po + 32 + 8 * g, (f32x4){o1[4 * g] * inv, o1[4 * g + 1] * inv, o1[4 * g + 2] * inv, o1[4 * g + 3] * inv});
            }
            if (hi == 0) { f32x2_t ml = {-negm, lrun}; *(f32x2_t*)(ax.part_ml + pidx * 2) = ml; }
        }
        return;
    }
    if constexpr (MODE == 2) {
        const int nsel = qb < 3 ? qb : 3;
        const size_t pbase = ((size_t)(b * 8 + h) * SEQ + qrow_idx) * 3;
        const float mref = -negm; float mm = mref;
        for (int s = 0; s < nsel; ++s) mm = __builtin_fmaxf(mm, ax.part_ml[(pbase + s) * 2]);
        const float w0 = __builtin_amdgcn_exp2f(mref - mm); lrun *= w0;
#pragma unroll
        for (int r = 0; r < 16; ++r) { o0[r] *= w0; o1[r] *= w0; }
        for (int s = 0; s < nsel; ++s) {
            const f32x2_t ml = *(const f32x2_t*)(ax.part_ml + (pbase + s) * 2);
            const float w = __builtin_amdgcn_exp2f(ml.x - mm) * ml.y; lrun += w;
            const bf16_t* po = ax.part_o + (pbase + s) * 64 + 4 * hi;
#pragma unroll
            for (int g = 0; g < 4; ++g) { const f32x4 a_ = ld4bf(po + 8 * g), c_ = ld4bf(po + 32 + 8 * g);
#pragma unroll
                for (int k = 0; k < 4; ++k) { o0[4 * g + k] += w * a_[k]; o1[4 * g + k] += w * c_[k]; } }
        }
    }
    const float inv = 1.f / lrun;
    bf16_t* orow = Og + (rowbase + q0 + wid * 32 + r32) * 512 + h * 64 + 4 * hi;
#pragma unroll
    for (int g = 0; g < 4; ++g) {
        st4(orow + 8 * g, (f32x4){o0[4 * g] * inv, o0[4 * g + 1] * inv, o0[4 * g + 2] * inv, o0[4 * g + 3] * inv});
        st4(orow + 32 + 8 * g, (f32x4){o1[4 * g] * inv, o1[4 * g + 1] * inv, o1[4 * g + 2] * inv, o1[4 * g + 3] * inv});
    }
}

__device__ __forceinline__ int moba_loff(int j) { return 7936 * j - 128 * j * (j - 1); }
constexpr int MOBA_LIST_PER_BH = 126976;
__device__ __forceinline__ void moba_select(const bf16_t* __restrict__ QA, const float* __restrict__ KMEAN, unsigned* CNT, unsigned short* LIST, int gid, LAS float* kms) {
    const int bh = gid >> 13, q = gid & 8191, b = bh >> 3, h = bh & 7, qb = q >> 8;
    { const int t_ = threadIdx.x; const int qbmax = (((gid - t_) & 8191) >> 8) + 1;
      __syncthreads();
      for (int i = t_; i < qbmax * 16; i += NTHREADS) { const int j = i >> 4, c = i & 15; *(LAS f32x4*)(kms + j * 64 + 4 * c) = *(const f32x4*)(KMEAN + (size_t)(b * 32 + j) * 512 + h * 64 + 4 * c); }
      __syncthreads(); }
    if (qb == 0) return;
    float qv[64];
    { const u32x4* qp = (const u32x4*)(QA + ((size_t)b * SEQ + q) * 512 + h * 64);
#pragma unroll
      for (int c = 0; c < 8; ++c) { const u32x4 w = qp[c];
          qv[8 * c + 0] = __uint_as_float(w.x << 16); qv[8 * c + 1] = __uint_as_float(w.x & 0xffff0000u); qv[8 * c + 2] = __uint_as_float(w.y << 16); qv[8 * c + 3] = __uint_as_float(w.y & 0xffff0000u);
          qv[8 * c + 4] = __uint_as_float(w.z << 16); qv[8 * c + 5] = __uint_as_float(w.z & 0xffff0000u); qv[8 * c + 6] = __uint_as_float(w.w << 16); qv[8 * c + 7] = __uint_as_float(w.w & 0xffff0000u); } }
    float v1 = -INFINITY, v2 = -INFINITY, v3 = -INFINITY; int i1 = -1, i2 = -1, i3 = -1;
    for (int j = 0; j < qb; ++j) {
        const LAS f32x4* km = (const LAS f32x4*)(kms + j * 64); float s0 = 0.f, s1 = 0.f;
#pragma unroll
        for (int c = 0; c < 16; c += 2) { const f32x4 a_ = km[c], c_ = km[c + 1];
            s0 += qv[4 * c] * a_[0] + qv[4 * c + 1] * a_[1] + qv[4 * c + 2] * a_[2] + qv[4 * c + 3] * a_[3];
            s1 += qv[4 * c + 4] * c_[0] + qv[4 * c + 5] * c_[1] + qv[4 * c + 6] * c_[2] + qv[4 * c + 7] * c_[3]; }
        const float s = s0 + s1;
        if (s > v1) { v3 = v2; i3 = i2; v2 = v1; i2 = i1; v1 = s; i1 = j; }
        else if (s > v2) { v3 = v2; i3 = i2; v2 = s; i2 = j; }
        else if (s > v3) { v3 = s; i3 = j; }
    }
    unsigned short* lb = LIST + (size_t)bh * MOBA_LIST_PER_BH;
    const int lane = gid & 63; int myn = 0;
    for (int j = 0; j < qb; ++j) { const unsigned long long m = __ballot((i1 == j) | (i2 == j) | (i3 == j)); if (lane == j) myn = __popcll(m); }
    unsigned mybase = 0u;
    if (lane < qb && myn > 0) mybase = atomicAdd(CNT + bh * 32 + lane, (unsigned)myn);
    for (int j = 0; j < qb; ++j) {
        const bool pick = (i1 == j) | (i2 == j) | (i3 == j); const unsigned long long m = __ballot(pick); const unsigned base = (unsigned)__shfl((int)mybase, j);
        if (pick) { const int rank = __popcll(m & ((1ull << lane) - 1ull)); const int slot_ = (i1 == j) ? 0 : (i2 == j) ? 1 : 2; lb[moba_loff(j) + base + rank] = (unsigned short)(q | (slot_ << 13)); }
    }
}

__device__ __forceinline__ int win_src_col(int p) {
    if (p < 1024) { const int base = p & ~63, w = p & 63, g = w >> 5, ww = w & 31; return base + (ww < 16 ? 16 * g + ww : 32 + 16 * g + (ww - 16)); }
    if (p < 2208) return p;
    if (p < 2304) return -1;
    return p - 96;
}
__device__ __forceinline__ void transpose_item(const float* __restrict__ W, int K, int Nsrc, int nblk, bf16_t* WT, const float* gk, bool winmap, LAS float* scr, int item, int lane) {
    const int kb = item / nblk, nb = item % nblk, k0 = 64 * kb, n0 = 32 * nb;
    const int np = n0 + (lane & 31); const int sc = winmap ? win_src_col(np) : np;
#pragma unroll 8
    for (int i = 0; i < 32; ++i) { const int kk = 2 * i + (lane >> 5); float v = (sc >= 0) ? W[(size_t)(k0 + kk) * Nsrc + sc] : 0.f; if (gk) v *= gk[k0 + kk]; scr[kk * 33 + (lane & 31)] = v; }
    asm volatile("s_waitcnt lgkmcnt(0)" ::: "memory");
    const int c = lane & 7;
#pragma unroll
    for (int j = 0; j < 4; ++j) { const int n = (lane >> 3) + 8 * j; const LAS float* s = scr + (8 * c) * 33 + n;
        u32x4 o; o.x = cvtpk(s[0 * 33], s[1 * 33]); o.y = cvtpk(s[2 * 33], s[3 * 33]); o.z = cvtpk(s[4 * 33], s[5 * 33]); o.w = cvtpk(s[6 * 33], s[7 * 33]);
        *(u32x4*)(WT + (size_t)(n0 + n) * K + k0 + 8 * c) = o; }
    asm volatile("s_waitcnt lgkmcnt(0)" ::: "memory");
}

#define GRID_SYNC() xcd_barrier(xbar)
struct Args { const float* in[15]; float* out; unsigned char* ws; };

__global__ void __launch_bounds__(NTHREADS, 2) fwd_megakernel(Args a) {
    extern __shared__ __attribute__((aligned(16))) unsigned char lds_raw[];
    LAS unsigned char* lds = (LAS unsigned char*)lds_raw;
    cg::grid_group grid = cg::this_grid();
    if (a.ws == nullptr) grid.sync();
    volatile LAS unsigned* MISC = (volatile LAS unsigned*)(lds + 131072 + 320);
    if (threadIdx.x < 32) MISC[threadIdx.x] = 0u;
    __syncthreads();
    XcdBarrier xbar = xcd_barrier_post((unsigned*)(a.ws + WS_BAR), MISC + 8);
    const int G = gridDim.x, bx = blockIdx.x; const int vcu = (G % 8 == 0) ? (bx % 8) * (G / 8) + bx / 8 : bx;
#if defined(PROBE_P0)
    for (int rep_ = 0; rep_ < 2; ++rep_)
#endif
    {
        unsigned char* wsl = a.ws;
        float* ROPE64 = (float*)(wsl + WS_ROPE64); float* ROPE32 = (float*)(wsl + WS_ROPE32); bf16_t* WIN = (bf16_t*)(wsl + WS_WIN); bf16_t* WQUP = (bf16_t*)(wsl + WS_WQUP); bf16_t* WKVUP = (bf16_t*)(wsl + WS_WKVUP); bf16_t* WOA = (bf16_t*)(wsl + WS_WOA); bf16_t* WOB = (bf16_t*)(wsl + WS_WOB); bf16_t* WOUT = (bf16_t*)(wsl + WS_WOUT); bf16_t* WFF1 = (bf16_t*)(wsl + WS_WFF1); bf16_t* WFF2 = (bf16_t*)(wsl + WS_WFF2); bf16_t* XN = (bf16_t*)(wsl + WS_XN); const float* x = a.in[0]; const float* g_mix = a.in[1]; const float* w_in = a.in[2]; const float* g_cq = a.in[4]; const float* w_q_up = a.in[5]; const float* g_ckv = a.in[6]; const float* w_kv_up = a.in[7]; const float* w_o_a = a.in[8]; const float* w_o_b = a.in[9]; const float* w_out = a.in[10]; const float* g_mlp = a.in[11]; const float* w_ff1 = a.in[12]; const float* w_ff2 = a.in[13];
        unsigned char* ws = wsl;
        int tid_ = threadIdx.x; asm volatile("" : "+v"(tid_)); const int tid = tid_, lane = tid & 63, wave = __builtin_amdgcn_readfirstlane(tid >> 6);
        const int gw = vcu * 8 + wave, NGW = G * 8;
        const int gt = bx * NTHREADS + tid, NGT = G * NTHREADS;
        for (int i = gt; i < (int)(WS_CTL_END / 4); i += NGT) ((float*)ws)[i] = 0.f;
        for (int i = gt; i < SEQ * 32; i += NGT) { const int pos = i >> 5, f = i & 31; const float inv = __builtin_amdgcn_exp2f(-(float)f * (13.287712379549449f / 32.f)); const float ang = (float)pos * inv;
            double rev = (double)ang * 0.15915494309189535; rev -= __builtin_rint(rev); const float fr = (float)rev;
            ROPE64[2 * i] = __builtin_amdgcn_cosf(fr); ROPE64[2 * i + 1] = __builtin_amdgcn_sinf(fr); }
        for (int i = gt; i < SEQ * 16; i += NGT) { const int pos = i >> 4, f = i & 15; const float inv = __builtin_amdgcn_exp2f(-(float)f * (13.287712379549449f / 16.f)); const float ang = (float)pos * inv;
            double rev = (double)ang * 0.15915494309189535; rev -= __builtin_rint(rev); const float fr = (float)rev;
            ROPE32[2 * i] = __builtin_amdgcn_cosf(fr); ROPE32[2 * i + 1] = __builtin_amdgcn_sinf(fr); }
        LAS float* scr = (LAS float*)(lds + wave * 16384);
        constexpr int I_IN = 16 * 136, I_QUP = 6 * 24, I_KVUP = 4 * 32, I_OA = 8 * 32, I_OUT = 16 * 32, I_FF1 = 16 * 128, I_FF2 = 64 * 32;
        constexpr int NITEMS = I_IN + I_QUP + I_KVUP + 2 * I_OA + I_OUT + I_FF1 + I_FF2;
        for (int it = gw; it < NITEMS; it += NGW) {
            int r = it;
            if (r < I_IN) { transpose_item(w_in, 1024, 4256, 136, WIN, nullptr, true, scr, r, lane); continue; } r -= I_IN;
            if (r < I_QUP) { transpose_item(w_q_up, 384, 768, 24, WQUP, g_cq, false, scr, r, lane); continue; } r -= I_QUP;
            if (r < I_KVUP) { transpose_item(w_kv_up, 256, 1024, 32, WKVUP, g_ckv, false, scr, r, lane); continue; } r -= I_KVUP;
            if (r < I_OA) { transpose_item(w_o_a, 512, 1024, 32, WOA, nullptr, false, scr, r, lane); continue; } r -= I_OA;
            if (r < I_OA) { transpose_item(w_o_b, 512, 1024, 32, WOB, nullptr, false, scr, r, lane); continue; } r -= I_OA;
            if (r < I_OUT) { transpose_item(w_out, 1024, 1024, 32, WOUT, nullptr, false, scr, r, lane); continue; } r -= I_OUT;
            if (r < I_FF1) { transpose_item(w_ff1, 1024, 4096, 128, WFF1, g_mlp, false, scr, r, lane); continue; } r -= I_FF1;
            transpose_item(w_ff2, 4096, 1024, 32, WFF2, nullptr, false, scr, r, lane);
        }
        f32x4 gm[4];
#pragma unroll
        for (int j = 0; j < 4; ++j) gm[j] = *((const f32x4*)g_mix + lane + 64 * j);
        for (int m0 = gw; m0 < M; m0 += 4 * NGW) {
            f32x4 v[4][4]; float s[4];
#pragma unroll
            for (int r = 0; r < 4; ++r) { const int m = m0 + r * NGW; const f32x4* xr = (const f32x4*)(x + (size_t)(m < M ? m : m0) * DM) + lane;
#pragma unroll
                for (int j = 0; j < 4; ++j) v[r][j] = xr[64 * j]; }
#pragma unroll
            for (int r = 0; r < 4; ++r) { s[r] = 0.f;
#pragma unroll
                for (int j = 0; j < 4; ++j) s[r] += (v[r][j][0] * v[r][j][0] + v[r][j][1] * v[r][j][1]) + (v[r][j][2] * v[r][j][2] + v[r][j][3] * v[r][j][3]); }
#pragma unroll
            for (int r = 0; r < 4; ++r) { const int m = m0 + r * NGW; const float rs = rsqrtf(wave_sum(s[r]) * (1.f / DM) + EPS);
                if (m < M) {
#pragma unroll
                    for (int j = 0; j < 4; ++j) st4(XN + (size_t)m * DM + 4 * (lane + 64 * j), v[r][j] * rs * gm[j]); } }
        }
    }
    GRID_SYNC();
    {
        unsigned char* wsl = a.ws;
        bf16_t* XN = (bf16_t*)(wsl + WS_XN); bf16_t* WIN = (bf16_t*)(wsl + WS_WIN); bf16_t* QA = (bf16_t*)(wsl + WS_QA); bf16_t* KA = (bf16_t*)(wsl + WS_KA); bf16_t* VA = (bf16_t*)(wsl + WS_VA); bf16_t* CQ = (bf16_t*)(wsl + WS_CQ); bf16_t* CKV = (bf16_t*)(wsl + WS_CKV); bf16_t* KB = (bf16_t*)(wsl + WS_KB); bf16_t* GT = (bf16_t*)a.out; float* ROWSS_Q = (float*)(wsl + WS_ROWSS_Q); float* ROWSS_KV = (float*)(wsl + WS_ROWSS_KV); float* KMEAN = (float*)(wsl + WS_KMEAN); float* ROPE64 = (float*)(wsl + WS_ROPE64); float* ROPE32 = (float*)(wsl + WS_ROPE32); const float* b_gate = a.in[3];
      pg8::Gemm g{XN, WIN, M, NIN, 1024}; pg8::StaticOrder S; S.init(M, NIN, G, bx);
#if defined(PROBE_P1)
      { EpiProj E{QA, KA, VA, CQ, CKV, KB, GT, ROWSS_Q, ROWSS_KV, KMEAN, ROPE64, ROPE32, b_gate, 1.f};
      pg8::gemm_phase<EpiProj, pg8::StaticOrder, true, true>(lds, g, S, E); } __syncthreads();
      { EpiProj E{QA, KA, VA, CQ, CKV, KB, GT, ROWSS_Q, ROWSS_KV, KMEAN, ROPE64, ROPE32, b_gate, 0.f};
      pg8::gemm_phase<EpiProj, pg8::StaticOrder, true, true>(lds, g, S, E); } }
#else
      EpiProj E{QA, KA, VA, CQ, CKV, KB, GT, ROWSS_Q, ROWSS_KV, KMEAN, ROPE64, ROPE32, b_gate, 1.f};
      pg8::gemm_phase<EpiProj, pg8::StaticOrder, true, true>(lds, g, S, E); }
#endif
    GRID_SYNC();
    {
        unsigned char* wsl = a.ws;
        int tid_ = threadIdx.x; asm volatile("" : "+v"(tid_));
        for (int gid = bx * NTHREADS + tid_; gid < 16 * SEQ; gid += G * NTHREADS)
            moba_select((const bf16_t*)(wsl + WS_QA), (const float*)(wsl + WS_KMEAN), (unsigned*)(wsl + WS_CNT), (unsigned short*)(wsl + WS_LIST), gid, (LAS float*)lds);
        __syncthreads();
    }
    {
        unsigned char* wsl = a.ws;
        bf16_t* CQ = (bf16_t*)(wsl + WS_CQ); bf16_t* WQUP = (bf16_t*)(wsl + WS_WQUP); bf16_t* QB = (bf16_t*)(wsl + WS_QB); float* ROWSS_Q = (float*)(wsl + WS_ROWSS_Q); float* ROPE32 = (float*)(wsl + WS_ROPE32);
      pg8::Gemm g{CQ, WQUP, M, 768, 384}; pg8::StaticOrder S; S.init(M, 768, G, bx); EpiQup E{QB, ROWSS_Q, ROPE32};
      pg8::gemm_phase<EpiQup, pg8::StaticOrder, true, true>(lds, g, S, E); }
    __syncthreads();
    {
        unsigned char* wsl = a.ws;
        bf16_t* CKV = (bf16_t*)(wsl + WS_CKV); bf16_t* WKVUP = (bf16_t*)(wsl + WS_WKVUP); bf16_t* KB = (bf16_t*)(wsl + WS_KB); bf16_t* VB = (bf16_t*)(wsl + WS_VB); float* ROWSS_KV = (float*)(wsl + WS_ROWSS_KV);
      pg8::Gemm g{CKV, WKVUP, M, 1024, 256}; pg8::StaticOrder S; S.init(M, 1024, G, bx); EpiKVup E{KB, VB, ROWSS_KV};
      pg8::gemm_phase<EpiKVup, pg8::StaticOrder, true, true>(lds, g, S, E); }
    GRID_SYNC();
    {
        unsigned char* wsl = a.ws;
        bf16_t *QB = (bf16_t*)(wsl + WS_QB), *KB = (bf16_t*)(wsl + WS_KB), *VB = (bf16_t*)(wsl + WS_VB), *OB = (bf16_t*)(wsl + WS_OB);
        bf16_t *QA = (bf16_t*)(wsl + WS_QA), *KA = (bf16_t*)(wsl + WS_KA), *VA = (bf16_t*)(wsl + WS_VA), *OA = (bf16_t*)(wsl + WS_OA);
        const unsigned* CNT = (const unsigned*)(wsl + WS_CNT); const unsigned short* LIST = (const unsigned short*)(wsl + WS_LIST);
        bf16_t* PART_O = (bf16_t*)(wsl + WS_PART_O); float* PART_ML = (float*)(wsl + WS_PART_ML);
        const MobaAux ax0{nullptr, 0, 0, PART_O, PART_ML};
#if defined(PROBE_REP)
        for (int rep_ = 0; rep_ < 2; ++rep_)
#endif
        for (int p = vcu; p < 256; p += G) {
            const int bh = p >> 4, s = p & 15, b = bh >> 3, h = bh & 7;
            attn_unit<96, 0>(b, h, 31 - s, QB, KB, VB, OB, ax0, lds); attn_unit<96, 0>(b, h, s, QB, KB, VB, OB, ax0, lds);
        }
        LAS int* pre = (LAS int*)(lds + 120000);
        { int tid_ = threadIdx.x; asm volatile("" : "+v"(tid_));
          if (tid_ < 64) { int c[8], sum = 0;
#pragma unroll
              for (int k = 0; k < 8; ++k) { const int t_ = 8 * tid_ + k; c[k] = (t_ < 496) ? (int)((CNT[(t_ / 31) * 32 + (t_ % 31)] + 255u) >> 8) : 0; sum += c[k]; }
              int incl = sum;
#pragma unroll
              for (int o = 1; o < 64; o <<= 1) { const int v = __shfl_up(incl, o); if (tid_ >= o) incl += v; }
              int run = incl - sum;
#pragma unroll
              for (int k = 0; k < 8; ++k) { const int t_ = 8 * tid_ + k; if (t_ <= 496) pre[t_] = run; run += c[k]; }
          }
          __syncthreads(); }
        const int nitems = pre[496];
#if defined(PROBE_GATHER)
        for (int rep2_ = 0; rep2_ < 2; ++rep2_)
#endif
        for (int I = vcu; I < nitems; I += G) {
            int lo = 0, hi_ = 496;
            while (hi_ - lo > 1) { const int mid = (lo + hi_) >> 1; if (pre[mid] <= I) lo = mid; else hi_ = mid; }
            const int bh = lo / 31, j = lo % 31;
            const MobaAux ax{LIST + (size_t)bh * MOBA_LIST_PER_BH + moba_loff(j), (int)CNT[bh * 32 + j], I - pre[lo], PART_O, PART_ML};
            attn_unit<64, 1>(bh >> 3, bh & 7, j, QA, KA, VA, OA, ax, lds);
        }
        GRID_SYNC();
#if defined(PROBE_OWN)
        for (int rep3_ = 0; rep3_ < 2; ++rep3_)
#endif
        for (int p = vcu; p < 512; p += G) attn_unit<64, 2>(p >> 8, (p >> 5) & 7, p & 31, QA, KA, VA, OA, ax0, lds);
    }
    GRID_SYNC();
    {
        unsigned char* wsl = a.ws;
        bf16_t* OA = (bf16_t*)(wsl + WS_OA); bf16_t* WOA = (bf16_t*)(wsl + WS_WOA); bf16_t* Z = (bf16_t*)(wsl + WS_Z); bf16_t* GT = (bf16_t*)a.out;
      pg8::Gemm g{OA, WOA, M, 1024, 512}; pg8::StaticOrder S; S.init(M, 1024, G, bx); EpiGate<false> E{Z, GT};
      pg8::gemm_phase<EpiGate<false>, pg8::StaticOrder, true, true>(lds, g, S, E); }
    __syncthreads();
    {
        unsigned char* wsl = a.ws;
        bf16_t* OB = (bf16_t*)(wsl + WS_OB); bf16_t* WOB = (bf16_t*)(wsl + WS_WOB); bf16_t* Z = (bf16_t*)(wsl + WS_Z); bf16_t* GT = (bf16_t*)a.out;
      pg8::Gemm g{OB, WOB, M, 1024, 512}; pg8::StaticOrder S; S.init(M, 1024, G, bx); EpiGate<true> E{Z, GT + (size_t)M * 1024};
      pg8::gemm_phase<EpiGate<true>, pg8::StaticOrder, true, true>(lds, g, S, E); }
    GRID_SYNC();
    {
        unsigned char* wsl = a.ws;
        bf16_t* Z = (bf16_t*)(wsl + WS_Z); bf16_t* WOUT = (bf16_t*)(wsl + WS_WOUT); const float* x = a.in[0]; float* out = a.out; bf16_t* X1B = (bf16_t*)(wsl + WS_X1B); float* ROWSS2 = (float*)(wsl + WS_ROWSS2);
      pg8::Gemm g{Z, WOUT, M, 1024, 1024}; pg8::StaticOrder S; S.init(M, 1024, G, bx);
#if defined(PROBE_P5)
      for (int rp_ = 0; rp_ < 2; ++rp_) { EpiOut E{x, out, X1B, ROWSS2, rp_ ? 0.f : 1.f};
      pg8::gemm_phase<EpiOut, pg8::StaticOrder, true, true>(lds, g, S, E); __syncthreads(); } }
#else
      EpiOut E{x, out, X1B, ROWSS2, 1.f};
      pg8::gemm_phase<EpiOut, pg8::StaticOrder, true, true>(lds, g, S, E); }
#endif
    GRID_SYNC();
#if defined(PROBE_P6)
    for (int rep_ = 0; rep_ < 2; ++rep_)
#endif
    {
        unsigned char* wsl = a.ws;
        bf16_t* X1B = (bf16_t*)(wsl + WS_X1B); bf16_t* WFF1 = (bf16_t*)(wsl + WS_WFF1); bf16_t* U = (bf16_t*)(wsl + WS_U); float* ROWSS2 = (float*)(wsl + WS_ROWSS2);
      pg8::Gemm g{X1B, WFF1, M, FF, 1024}; pg8::StaticOrder S; S.init(M, FF, G, bx); EpiFF1 E{U, ROWSS2};
      pg8::gemm_phase<EpiFF1, pg8::StaticOrder, true, true>(lds, g, S, E); __syncthreads(); }
    GRID_SYNC();
    {
        unsigned char* wsl = a.ws;
        bf16_t* U = (bf16_t*)(wsl + WS_U); bf16_t* WFF2 = (bf16_t*)(wsl + WS_WFF2); float* out = a.out;
      pg8::Gemm g{U, WFF2, M, 1024, FF}; pg8::StaticOrder S; S.init(M, 1024, G, bx);
      EpiFF2 E{out, (const bf16_t*)(wsl + WS_X1B)};
      pg8::gemm_phase<EpiFF2, pg8::StaticOrder, true, true>(lds, g, S, E); }
    GRID_SYNC();
    {
        float* out = a.out; const float* g_final = a.in[14];
        int tid_ = threadIdx.x; asm volatile("" : "+v"(tid_)); const int tid = tid_, lane = tid & 63, wave = __builtin_amdgcn_readfirstlane(tid >> 6);
        const int gw = vcu * 8 + wave, NGW = G * 8;
        f32x4 gf[4];
#pragma unroll
        for (int j = 0; j < 4; ++j) gf[j] = *((const f32x4*)g_final + lane + 64 * j);
        for (int m0 = gw; m0 < M; m0 += 4 * NGW) {
            f32x4 v[4][4]; float s[4];
#pragma unroll
            for (int r = 0; r < 4; ++r) { const int m = m0 + r * NGW; const f32x4* xr = (const f32x4*)(out + (size_t)(m < M ? m : m0) * DM) + lane;
#pragma unroll
                for (int j = 0; j < 4; ++j) v[r][j] = xr[64 * j]; }
#pragma unroll
            for (int r = 0; r < 4; ++r) { s[r] = 0.f;
#pragma unroll
                for (int j = 0; j < 4; ++j) s[r] += (v[r][j][0] * v[r][j][0] + v[r][j][1] * v[r][j][1]) + (v[r][j][2] * v[r][j][2] + v[r][j][3] * v[r][j][3]); }
#pragma unroll
            for (int r = 0; r < 4; ++r) { const int m = m0 + r * NGW; const float rs = rsqrtf(wave_sum(s[r]) * (1.f / DM) + EPS);
                if (m < M) { f32x4* xw = (f32x4*)(out + (size_t)m * DM) + lane;
#pragma unroll
                    for (int j = 0; j < 4; ++j) xw[64 * j] = v[r][j] * rs * gf[j]; } }
        }
    }
}

extern "C" void kernel_launch(void* const* d_in, const int* in_sizes, int n_in, void* d_out, int out_size, void* d_ws, size_t ws_size, hipStream_t stream) {
    static int grid = 0;
    if (grid == 0) {
        if (n_in != 15 || out_size != M * DM || ws_size < WS_END) { fprintf(stderr, "kernel_launch: unexpected shapes (n_in %d out %d ws %zu)\n", n_in, out_size, ws_size); grid = -1; return; }
        int dev = 0, cus = 0, per_cu = 0;
        hipGetDevice(&dev); hipDeviceGetAttribute(&cus, hipDeviceAttributeMultiprocessorCount, dev);
        if (hipFuncSetAttribute((const void*)fwd_megakernel, hipFuncAttributeMaxDynamicSharedMemorySize, LDS_BYTES) != hipSuccess) { fprintf(stderr, "kernel_launch: hipFuncSetAttribute failed\n"); grid = -1; return; }
        if (hipOccupancyMaxActiveBlocksPerMultiprocessor(&per_cu, (const void*)fwd_megakernel, NTHREADS, LDS_BYTES) != hipSuccess || per_cu < 1) { fprintf(stderr, "kernel_launch: occupancy query gave %d\n", per_cu); per_cu = 1; }
        (void)hipGetLastError();
        grid = cus * per_cu;
    }
    if (grid < 0) return;
    if (hipMemsetAsync((char*)d_ws + WS_BAR, 0, WS_BAR_BYTES, stream) != hipSuccess) { fprintf(stderr, "kernel_launch: memset failed\n"); return; }
    Args a{};
    for (int i = 0; i < 15; ++i) a.in[i] = (const float*)d_in[i];
    a.out = (float*)d_out; a.ws = (unsigned char*)d_ws;
    void* args[] = {&a};
    hipError_t e = hipLaunchCooperativeKernel((const void*)fwd_megakernel, dim3(grid), dim3(NTHREADS), args, LDS_BYTES, stream);
    if (e != hipSuccess) fprintf(stderr, "cooperative launch failed: %s (grid %d)\n", hipGetErrorString(e), grid);
}
```
